# Optimizing an MI355X kernel written in HIP

```python
import math
import jax, jax.numpy as jnp
from jax import lax
import numpy as np

D_MODEL = 1024
BATCH = 8
SEQ = 4096
DEPTH = 4

GRID_W = 64
CTX_LEN = 256
N_MIXERS = 3
N_MOD = 9
ROPE_THETA = 10000.0
NORM_EPS = 1e-6
Q_BLOCK = 128
NEG_INF = -1e30
D_FF = ((8 * D_MODEL // 3 + 127) // 128) * 128

A_HEADS = D_MODEL // 128
A_NOPE = 128
A_ROPE = 64
A_V = 128
A_Q_LORA = 3 * D_MODEL // 8
A_KV_LORA = D_MODEL // 4
A_IN = A_Q_LORA + A_KV_LORA + A_ROPE

B_HEAD_DIM = 64
B_HEADS = D_MODEL // (2 * B_HEAD_DIM)
B_WIDTH = B_HEADS * 2 * B_HEAD_DIM

C_HEAD_DIM = 64
C_HEADS = D_MODEL // C_HEAD_DIM
C_KV_HEADS = C_HEADS // 4
C_GROUP = C_HEADS // C_KV_HEADS
C_WINDOW = 128

N_A = len(range(0, DEPTH, N_MIXERS))
N_B = len(range(1, DEPTH, N_MIXERS))
N_C = len(range(2, DEPTH, N_MIXERS))

kernel_name = "hybrid_dit_mla_diff_swa_macaron"


def rmsnorm(x, g):
    xf = x.astype(jnp.float32)
    xf = xf * lax.rsqrt(jnp.mean(jnp.square(xf), axis=-1, keepdims=True) + NORM_EPS)
    return (xf * g.astype(jnp.float32)).astype(x.dtype)


def modulate(h, shift, scale):
    return h * (1.0 + scale) + shift


def swiglu(h, w_in, w_out):
    gate, up = jnp.split(h @ w_in, 2, axis=-1)
    return (jax.nn.silu(gate) * up) @ w_out


def ffn_half_step(x, g, shift, scale, gate, w_in, w_out):
    return x + 0.5 * gate * swiglu(modulate(rmsnorm(x, g), shift, scale), w_in, w_out)


def merge_heads(o):
    Bn, H, L, d = o.shape
    return o.transpose(0, 2, 1, 3).reshape(Bn, L, H * d)


def softmax_f32(s, scale):
    return jax.nn.softmax(s.astype(jnp.float32) * scale, axis=-1)


def axial_rope_tables(row, col, dim, dtype):
    quarter = dim // 4
    inv_freq = ROPE_THETA ** (-jnp.arange(quarter, dtype=jnp.float32) / quarter)
    ang = jnp.stack([row.astype(jnp.float32)[:, None] * inv_freq,
                     col.astype(jnp.float32)[:, None] * inv_freq], axis=1)
    return jnp.cos(ang).astype(dtype), jnp.sin(ang).astype(dtype)


def apply_axial_rope(x, cos, sin):
    q = x.shape[-1] // 4
    xs = x.reshape(*x.shape[:-1], 2, 2, q)
    x1, x2 = xs[..., 0, :], xs[..., 1, :]
    out = jnp.stack([x1 * cos - x2 * sin, x2 * cos + x1 * sin], axis=-2)
    return out.reshape(x.shape)


def sweep_query_blocks(fn, q):
    *lead, S, d = q.shape
    nb = S // Q_BLOCK
    blocks = jnp.moveaxis(q.reshape(*lead, nb, Q_BLOCK, d), -3, 0)
    out = jnp.moveaxis(lax.map(fn, blocks), 0, -3)
    return out.reshape(*out.shape[:-3], nb * Q_BLOCK, out.shape[-1])


def mla_mixer(h_lat, h_ctx, row, col, w_in, g_q, g_kv, w_qb, w_kvb, w_o, need_ctx_out):
    scale = (A_NOPE + A_ROPE) ** -0.5
    cos, sin = axial_rope_tables(row, col, A_ROPE, h_lat.dtype)

    def compress(h):
        a = h @ w_in
        return (a[..., :A_Q_LORA],
                rmsnorm(a[..., A_Q_LORA:A_Q_LORA + A_KV_LORA], g_kv),
                a[..., A_Q_LORA + A_KV_LORA:])

    def queries(cq):
        Bn, L, _ = cq.shape
        return (rmsnorm(cq, g_q) @ w_qb).reshape(Bn, L, A_HEADS, A_NOPE + A_ROPE).transpose(0, 2, 1, 3)

    def keys_values(ckv, k_rope):
        Bn, L, _ = ckv.shape
        kv = (ckv @ w_kvb).reshape(Bn, L, A_HEADS, A_NOPE + A_V).transpose(0, 2, 1, 3)
        k_rope = jnp.broadcast_to(k_rope[:, None], (Bn, A_HEADS, L, A_ROPE))
        return jnp.concatenate([kv[..., :A_NOPE], k_rope], axis=-1), kv[..., A_NOPE:]

    cq_l, ckv_l, kr_l = compress(h_lat)
    cq_c, ckv_c, kr_c = compress(h_ctx)
    q_l = queries(cq_l)
    q_l = jnp.concatenate([q_l[..., :A_NOPE], apply_axial_rope(q_l[..., A_NOPE:], cos, sin)], axis=-1)
    k_l, v_l = keys_values(ckv_l, apply_axial_rope(kr_l, cos, sin))
    k_c, v_c = keys_values(ckv_c, kr_c)
    k_all = jnp.concatenate([k_c, k_l], axis=2)
    v_all = jnp.concatenate([v_c, v_l], axis=2)

    def attend(qb):
        p = softmax_f32(jnp.einsum('bhqd,bhkd->bhqk', qb, k_all), scale)
        return jnp.einsum('bhqk,bhkd->bhqd', p.astype(v_all.dtype), v_all)

    y_lat = merge_heads(sweep_query_blocks(attend, q_l)) @ w_o
    y_ctx = None
    if need_ctx_out:
        q_c = queries(cq_c)
        p = softmax_f32(jnp.einsum('bhqd,bhkd->bhqk', q_c, k_c), scale)
        y_ctx = merge_heads(jnp.einsum('bhqk,bhkd->bhqd', p.astype(v_c.dtype), v_c)) @ w_o
    return y_lat, y_ctx


def diff_mixer(h_lat, h_ctx, row, col, w_qkv, lam_params, g_sub, w_o, layer_idx, need_ctx_out):
    d = B_HEAD_DIM
    scale = d ** -0.5
    lam_init = 0.8 - 0.6 * math.exp(-0.3 * layer_idx)
    lp = lam_params.astype(jnp.float32)
    lam = jnp.exp(jnp.sum(lp[0] * lp[1])) - jnp.exp(jnp.sum(lp[2] * lp[3])) + lam_init
    cos, sin = axial_rope_tables(row, col, d, h_lat.dtype)

    def project(h):
        Bn, L, _ = h.shape
        qkv = h @ w_qkv
        q = qkv[..., :B_WIDTH].reshape(Bn, L, B_HEADS, 2, d).transpose(0, 2, 3, 1, 4)
        k = qkv[..., B_WIDTH:2 * B_WIDTH].reshape(Bn, L, B_HEADS, 2, d).transpose(0, 2, 3, 1, 4)
        v = qkv[..., 2 * B_WIDTH:].reshape(Bn, L, B_HEADS, 2 * d).transpose(0, 2, 1, 3)
        return q, k, v

    def diff_attend(q, k, v):
        p = softmax_f32(jnp.einsum('bhmqd,bhmkd->bhmqk', q, k), scale)
        a = p[:, :, 0] - lam * p[:, :, 1]
        return jnp.einsum('bhqk,bhkd->bhqd', a.astype(v.dtype), v)

    def finish(o):
        return merge_heads(rmsnorm(o, g_sub) * (1.0 - lam_init)) @ w_o

    q_l, k_l, v_l = project(h_lat)
    q_c, k_c, v_c = project(h_ctx)
    q_l = apply_axial_rope(q_l, cos, sin)
    k_l = apply_axial_rope(k_l, cos, sin)
    k_all = jnp.concatenate([k_c, k_l], axis=3)
    v_all = jnp.concatenate([v_c, v_l], axis=2)
    y_lat = finish(sweep_query_blocks(lambda qb: diff_attend(qb, k_all, v_all), q_l))
    y_ctx = finish(diff_attend(q_c, k_c, v_c)) if need_ctx_out else None
    return y_lat, y_ctx


def swa_mixer(h_lat, h_ctx, row, col, w_qkv, sink, w_o, need_ctx_out):
    d = C_HEAD_DIM
    scale = d ** -0.5
    S = h_lat.shape[1]
    cos, sin = axial_rope_tables(row, col, d, h_lat.dtype)
    nq, nkv = C_HEADS * d, C_KV_HEADS * d

    def project(h):
        Bn, L, _ = h.shape
        qkv = h @ w_qkv
        q = qkv[..., :nq].reshape(Bn, L, C_KV_HEADS, C_GROUP, d).transpose(0, 2, 3, 1, 4)
        k = qkv[..., nq:nq + nkv].reshape(Bn, L, C_KV_HEADS, d).transpose(0, 2, 1, 3)
        v = qkv[..., nq + nkv:].reshape(Bn, L, C_KV_HEADS, d).transpose(0, 2, 1, 3)
        return q, k, v

    sink_logit = sink.astype(jnp.float32).reshape(C_KV_HEADS, C_GROUP)[None, :, :, None, None]

    def sink_softmax(logits):
        sl = jnp.broadcast_to(sink_logit, logits.shape[:-1] + (1,))
        return jax.nn.softmax(jnp.concatenate([sl, logits], axis=-1), axis=-1)[..., 1:]

    def merge(o):
        Bn, _, _, L, _ = o.shape
        return o.transpose(0, 3, 1, 2, 4).reshape(Bn, L, nq) @ w_o

    q_l, k_l, v_l = project(h_lat)
    q_c, k_c, v_c = project(h_ctx)
    q_l = apply_axial_rope(q_l, cos, sin)
    k_l = apply_axial_rope(k_l, cos, sin)
    n_ctx = k_c.shape[2]
    pad = ((0, 0), (0, 0), (Q_BLOCK, Q_BLOCK), (0, 0))
    k_pad = jnp.pad(k_l, pad)
    v_pad = jnp.pad(v_l, pad)
    offs_q = jnp.arange(Q_BLOCK, dtype=jnp.int32)
    offs_k = jnp.arange(3 * Q_BLOCK, dtype=jnp.int32) - Q_BLOCK

    def band_block(start):
        qb = lax.dynamic_slice_in_dim(q_l, start, Q_BLOCK, axis=3)
        kb = lax.dynamic_slice_in_dim(k_pad, start, 3 * Q_BLOCK, axis=2)
        vb = lax.dynamic_slice_in_dim(v_pad, start, 3 * Q_BLOCK, axis=2)
        key_pos = start + offs_k
        valid = ((jnp.abs(offs_k[None, :] - offs_q[:, None]) <= C_WINDOW)
                 & (key_pos >= 0)[None, :] & (key_pos < S)[None, :])
        s_ctx = jnp.einsum('bhgqd,bhkd->bhgqk', qb, k_c).astype(jnp.float32) * scale
        s_win = jnp.where(valid, jnp.einsum('bhgqd,bhkd->bhgqk', qb, kb).astype(jnp.float32) * scale, NEG_INF)
        p = sink_softmax(jnp.concatenate([s_ctx, s_win], axis=-1)).astype(v_c.dtype)
        return (jnp.einsum('bhgqk,bhkd->bhgqd', p[..., :n_ctx], v_c)
                + jnp.einsum('bhgqk,bhkd->bhgqd', p[..., n_ctx:], vb))

    o = lax.map(band_block, jnp.arange(S // Q_BLOCK, dtype=jnp.int32) * Q_BLOCK)
    o = jnp.moveaxis(o, 0, 3)
    o = o.reshape(*o.shape[:3], S, d)
    y_lat = merge(o)
    y_ctx = None
    if need_ctx_out:
        p = sink_softmax(jnp.einsum('bhgqd,bhkd->bhgqk', q_c, k_c).astype(jnp.float32) * scale)
        y_ctx = merge(jnp.einsum('bhgqk,bhkd->bhgqd', p.astype(v_c.dtype), v_c))
    return y_lat, y_ctx


def setup_inputs(seed: int = 0) -> dict:
    key = jax.random.key(seed)
    ks = jax.random.split(key, 24)

    def nrm(k, shape, s):
        return jax.random.normal(k, shape, jnp.float32) * s

    def gain(k, shape):
        return 1.0 + 0.05 * jax.random.normal(k, shape, jnp.float32)

    return {
        "x": nrm(ks[0], (BATCH, SEQ, D_MODEL), 1.0),
        "c": nrm(ks[1], (BATCH, D_MODEL), 1.0),
        "ctx": nrm(ks[2], (BATCH, CTX_LEN, D_MODEL), 1.0),
        "c_ctx": nrm(ks[3], (D_MODEL,), 1.0),
        "w_mod": nrm(ks[4], (DEPTH, D_MODEL, N_MOD * D_MODEL), 0.5 * D_MODEL ** -0.5),
        "b_mod": nrm(ks[5], (DEPTH, N_MOD * D_MODEL), 0.02),
        "g_norm": gain(ks[6], (DEPTH, 3, D_MODEL)),
        "w_ffn_in": nrm(ks[7], (DEPTH, 2, D_MODEL, 2 * D_FF), D_MODEL ** -0.5),
        "w_ffn_out": nrm(ks[8], (DEPTH, 2, D_FF, D_MODEL), D_FF ** -0.5),
        "a_w_in": nrm(ks[9], (N_A, D_MODEL, A_IN), D_MODEL ** -0.5),
        "a_g_q": gain(ks[10], (N_A, A_Q_LORA)),
        "a_g_kv": gain(ks[11], (N_A, A_KV_LORA)),
        "a_w_qb": nrm(ks[12], (N_A, A_Q_LORA, A_HEADS * (A_NOPE + A_ROPE)), A_Q_LORA ** -0.5),
        "a_w_kvb": nrm(ks[13], (N_A, A_KV_LORA, A_HEADS * (A_NOPE + A_V)), A_KV_LORA ** -0.5),
        "a_w_o": nrm(ks[14], (N_A, A_HEADS * A_V, D_MODEL), (A_HEADS * A_V) ** -0.5),
        "b_w_qkv": nrm(ks[15], (N_B, D_MODEL, 3 * B_WIDTH), D_MODEL ** -0.5),
        "b_lambda": nrm(ks[16], (N_B, 4, B_HEAD_DIM), 0.1),
        "b_g_sub": gain(ks[17], (N_B, 2 * B_HEAD_DIM)),
        "b_w_o": nrm(ks[18], (N_B, B_WIDTH, D_MODEL), B_WIDTH ** -0.5),
        "c_w_qkv": nrm(ks[19], (N_C, D_MODEL, (C_HEADS + 2 * C_KV_HEADS) * C_HEAD_DIM), D_MODEL ** -0.5),
        "c_sink": nrm(ks[20], (N_C, C_HEADS), 1.0),
        "c_w_o": nrm(ks[21], (N_C, C_HEADS * C_HEAD_DIM, D_MODEL), (C_HEADS * C_HEAD_DIM) ** -0.5),
        "g_final": gain(ks[22], (D_MODEL,)),
    }


def reference(x, c, ctx, c_ctx, w_mod, b_mod, g_norm, w_ffn_in, w_ffn_out,
              a_w_in, a_g_q, a_g_kv, a_w_qb, a_w_kvb, a_w_o,
              b_w_qkv, b_lambda, b_g_sub, b_w_o,
              c_w_qkv, c_sink, c_w_o, g_final):
    Bn, S, _ = x.shape
    rows = S // GRID_W
    row = jnp.repeat(jnp.arange(rows, dtype=jnp.int32), GRID_W)
    col = jnp.tile(jnp.arange(GRID_W, dtype=jnp.int32), rows)
    silu_c = jax.nn.silu(c)
    silu_cc = jax.nn.silu(c_ctx)

    for i in range(DEPTH):
        need_ctx = i < DEPTH - 1
        mod_l = (silu_c @ w_mod[i] + b_mod[i]).reshape(Bn, N_MOD, 1, D_MODEL)
        mod_c = (silu_cc @ w_mod[i] + b_mod[i]).reshape(N_MOD, D_MODEL)

        x = ffn_half_step(x, g_norm[i, 0], mod_l[:, 0], mod_l[:, 1], mod_l[:, 2], w_ffn_in[i, 0], w_ffn_out[i, 0])
        ctx = ffn_half_step(ctx, g_norm[i, 0], mod_c[0], mod_c[1], mod_c[2], w_ffn_in[i, 0], w_ffn_out[i, 0])

        h_l = modulate(rmsnorm(x, g_norm[i, 1]), mod_l[:, 3], mod_l[:, 4])
        h_c = modulate(rmsnorm(ctx, g_norm[i, 1]), mod_c[3], mod_c[4])
        kind, j = i % N_MIXERS, i // N_MIXERS
        if kind == 0:
            y_l, y_c = mla_mixer(h_l, h_c, row, col, a_w_in[j], a_g_q[j], a_g_kv[j],
                                 a_w_qb[j], a_w_kvb[j], a_w_o[j], need_ctx)
        elif kind == 1:
            y_l, y_c = diff_mixer(h_l, h_c, row, col, b_w_qkv[j], b_lambda[j], b_g_sub[j], b_w_o[j], i, need_ctx)
        else:
            y_l, y_c = swa_mixer(h_l, h_c, row, col, c_w_qkv[j], c_sink[j], c_w_o[j], need_ctx)
        x = x + mod_l[:, 5] * y_l

        x = ffn_half_step(x, g_norm[i, 2], mod_l[:, 6], mod_l[:, 7], mod_l[:, 8], w_ffn_in[i, 1], w_ffn_out[i, 1])
        if need_ctx:
            ctx = ctx + mod_c[5] * y_c
            ctx = ffn_half_step(ctx, g_norm[i, 2], mod_c[6], mod_c[7], mod_c[8], w_ffn_in[i, 1], w_ffn_out[i, 1])

    return rmsnorm(x, g_final)
```

```cpp
#include <hip/hip_runtime.h>
#include <hip/hip_cooperative_groups.h>
#include <cstdio>
#include <cstdint>
namespace cg = cooperative_groups;
__device__ __forceinline__ float opaque_zero() { float z; asm volatile("v_mov_b32 %0, 0" : "=v"(z)); return z; }
namespace pg8 {
#define PG8_LAS __attribute__((address_space(3)))
typedef unsigned short bf16_t;
typedef short bf16x8 __attribute__((ext_vector_type(8)));
typedef float f32x4 __attribute__((ext_vector_type(4)));
typedef unsigned u32x4 __attribute__((ext_vector_type(4)));
constexpr int BM = 256, BK = 64, HALF = 128, HTB = HALF * BK * 2  , STAGE_BYTES = 8 * HTB, NXCD = 8, WGM = 8;

__host__ __device__ __forceinline__ int lds_byte(int r, int c) { const int st = (r >> 4) * 2 + (c >> 5), rr = r & 15, cc = c & 31, ob = rr * 64 + cc * 2; return st * 1024 + (ob ^ (((ob >> 9) & 1) << 5)); }
__host__ __device__ __forceinline__ void stage_rc(int b, int& R, int& C) { const int st = b / 1024, sb = b % 1024, swz = sb ^ (((sb >> 9) & 1) << 5); R = (st >> 1) * 16 + swz / 64; C = (st & 1) * 32 + (swz % 64) / 2; }
__host__ __device__ __forceinline__ int perm32(int rho) { const int n = rho >> 4, i = rho & 15; return 8 * (i >> 2) + 4 * n + (i & 3); }

struct Unit { int pm, pn, k0, nt, split; };
struct Gemm { const bf16_t* A; const bf16_t* Bt; int M, N, K; };

struct StaticOrder {
    int nM, nN, nwg, G, c, ntk, nfull, L, P;
    __host__ __device__ void init(int M, int N, int G_, int c_, int ntk_, bool split) {
        nM = M / BM; nN = N / BM; G = G_; c = c_; ntk = ntk_; L = 0; P = 1;
        if (split && nM == 136 && (128 * nN) % G == 0 && G % (8 * nN) == 0 && G / (8 * nN) <= ntk / 2) { nM = 128; L = 8 * nN; P = G / L; }
        nwg = nM * nN; nfull = nwg;
    }
    __host__ __device__ void map(int wgid, Unit& u) const {
        { const int q = nwg / NXCD, r = nwg % NXCD, xcd = wgid % NXCD, off = wgid / NXCD; wgid = (xcd < r ? xcd * (q + 1) : r * (q + 1) + (xcd - r) * q) + off; }
        const int nig = WGM * nN, gid = wgid / nig, fm = gid * WGM, gsz = (nM - fm) < WGM ? (nM - fm) : WGM;
        u.pm = fm + ((wgid % nig) % gsz); u.pn = (wgid % nig) / gsz;
    }
    __host__ __device__ bool next(int i, Unit& u) const {
        if (L > 0 && (c & 1)) { if (i == 0) { if (c >= L * P) return false; goto piece; } --i; if ((long)i * G + c >= nfull) return false; }
        { const long Lid = (long)i * G + c;
          if (Lid < nfull) { map((int)Lid, u); u.k0 = 0; u.nt = ntk; u.split = 0; return true; } }
        if (L == 0 || i != nfull / G || c >= L * P) return false;
        piece:
        const int j = c / P, piece = c % P, pairs = ntk / 2, base = pairs / P, rem = pairs % P;
        u.pm = 128 + j / nN; u.pn = j % nN;
        u.k0 = 2 * (piece * base + (piece < rem ? piece : rem)); u.nt = 2 * (base + (piece < rem ? 1 : 0)); u.split = piece + 1; return true;
    }
    __device__ __forceinline__ void a_ready(const Unit&) const {}
    __device__ __forceinline__ void done(const Unit&) const {}
};

template <class Epi, class Sched, bool ALIGN_EPI = false, bool SP2 = false>
__device__ __forceinline__ void gemm_phase(PG8_LAS unsigned char* lds, const Gemm g, const Sched& S, const Epi& E) {
    int tid_ = threadIdx.x; asm volatile("" : "+v"(tid_));
    const int tid = tid_, wid = __builtin_amdgcn_readfirstlane(tid >> 6), lane = tid & 63, wr = wid >> 2, wc = wid & 3, fr = lane & 15, fq = lane >> 4;
    const int K = g.K, nt = K / BK;
    unsigned voffA[2], voffB[2];
#pragma unroll
    for (int i = 0; i < 2; ++i) { int R, C; stage_rc(tid * 16 + i * 8192, R, C); const int Rb = Epi::PERM ? ((R & ~31) + perm32(R & 31)) : R;
        voffA[i] = (unsigned)(R * K + C) * 2u; voffB[i] = (unsigned)(Rb * K + C) * 2u; }
    const size_t kstep = (size_t)(BK * 2);
    const size_t hstep = (size_t)HALF * K * 2;
    const size_t tstep = 2 * hstep;
    const unsigned ldsw = (unsigned)wid * 1024u;
    const int aoff = lds_byte(wr * 64 + fr, fq * 8), boff = lds_byte(wc * 32 + fr, fq * 8);
#define PG8_SA(b, h) (((b) * 2 + (h)) * HTB)
#define PG8_SB(b, h) ((4 + (b) * 2 + (h)) * HTB)
#define PG8_STAGE(bufoff, gbase, voff) do { _Pragma("unroll") for (int _i = 0; _i < 2; ++_i) \
        __builtin_amdgcn_global_load_lds((const unsigned*)((const char*)(gbase) + (voff)[_i]), (PG8_LAS unsigned*)(lds + (bufoff) + ldsw + _i * 8192), 16, 0, 0); } while (0)
#define PG8_LDA(dst, b, h) do { _Pragma("unroll") for (int m = 0; m < 4; ++m) _Pragma("unroll") for (int k = 0; k < 2; ++k) dst[m][k] = *(const PG8_LAS bf16x8*)(lds + PG8_SA(b, h) + aoff + m * 2048 + k * 1024); } while (0)
#define PG8_LDB(dst, b, h) do { _Pragma("unroll") for (int n = 0; n < 2; ++n) _Pragma("unroll") for (int k = 0; k < 2; ++k) dst[n][k] = *(const PG8_LAS bf16x8*)(lds + PG8_SB(b, h) + boff + n * 2048 + k * 1024); } while (0)
#define PG8_MMA(ai, bj, At, Bt) do { __builtin_amdgcn_s_setprio(1); _Pragma("unroll") for (int m = 0; m < 4; ++m) _Pragma("unroll") for (int n = 0; n < 2; ++n) _Pragma("unroll") for (int k = 0; k < 2; ++k) \
        acc[ai][bj][m][n] = __builtin_amdgcn_mfma_f32_16x16x32_bf16(Bt[n][k], At[m][k], acc[ai][bj][m][n], 0, 0, 0); __builtin_amdgcn_s_setprio(0); } while (0)
#define PG8_WAIT_V(n) asm volatile("s_waitcnt vmcnt(" #n ")" ::: "memory")
#define PG8_WAIT_L(n) asm volatile("s_waitcnt lgkmcnt(" #n ")" ::: "memory")
#define PG8_BAR __builtin_amdgcn_s_barrier()
#define PG8_SCHED __builtin_amdgcn_sched_barrier(0)
    Unit cur, nxt; int ui = 0;
    if (!S.next(0, cur)) return;
    f32x4 acc[2][2][4][2];
#pragma unroll
    for (int a = 0; a < 2; ++a)
#pragma unroll
        for (int b = 0; b < 2; ++b)
#pragma unroll
            for (int m = 0; m < 4; ++m)
#pragma unroll
                for (int n = 0; n < 2; ++n) { const float z0_ = opaque_zero(); acc[a][b][m][n] = (f32x4){z0_, z0_, z0_, z0_}; }
    bf16x8 At[4][2], B0[2][2], B1[2][2];
    const char* cA = (const char*)g.A + (size_t)cur.pm * tstep + (size_t)cur.k0 * kstep; const char* cB = (const char*)g.Bt + (size_t)cur.pn * tstep + (size_t)cur.k0 * kstep;
    S.a_ready(cur);
    if constexpr (SP2) {
        PG8_STAGE(PG8_SB(0, 0), cB, voffB); PG8_STAGE(PG8_SB(0, 1), cB + hstep, voffB); PG8_STAGE(PG8_SA(0, 0), cA, voffA); PG8_STAGE(PG8_SA(0, 1), cA + hstep, voffA);
        if (wr == 1) PG8_BAR;
        PG8_WAIT_V(2); PG8_BAR;
        PG8_STAGE(PG8_SB(1, 0), cB + kstep, voffB); PG8_STAGE(PG8_SA(1, 0), cA + kstep, voffA); PG8_STAGE(PG8_SB(1, 1), cB + hstep + kstep, voffB);
        PG8_WAIT_V(6); PG8_BAR;
    } else {
        PG8_STAGE(PG8_SB(0, 0), cB, voffB); PG8_STAGE(PG8_SA(0, 0), cA, voffA); PG8_STAGE(PG8_SB(0, 1), cB + hstep, voffB); PG8_STAGE(PG8_SA(0, 1), cA + hstep, voffA);
        if (wr == 1) PG8_BAR;
        PG8_WAIT_V(4); PG8_BAR;
        PG8_STAGE(PG8_SB(1, 0), cB + kstep, voffB); PG8_STAGE(PG8_SA(1, 0), cA + kstep, voffA); PG8_STAGE(PG8_SB(1, 1), cB + hstep + kstep, voffB);
        PG8_WAIT_V(6); PG8_BAR;
    }
    for (;;) {
        const bool has_next = S.next(ui + 1, nxt);
        const char* nA = has_next ? (const char*)g.A + (size_t)nxt.pm * tstep + (size_t)nxt.k0 * kstep : cA; const char* nB = has_next ? (const char*)g.Bt + (size_t)nxt.pn * tstep + (size_t)nxt.k0 * kstep : cB;
        const int nt_u = cur.nt;
        for (int t = 0; t < nt_u; t += 2) {
            const bool last = (t == nt_u - 2);
            const char* a1 = cA + (size_t)(t + 1) * kstep;
            const char* a2 = last ? nA : cA + (size_t)(t + 2) * kstep; const char* b2 = last ? nB : cB + (size_t)(t + 2) * kstep;
            const char* a3 = a2 + kstep; const char* b3 = b2 + kstep;
            if (last && has_next) S.a_ready(nxt);
            if constexpr (SP2) {
            PG8_LDB(B0, 0, 0); PG8_LDB(B1, 0, 1); PG8_SCHED; PG8_LDA(At, 0, 0); PG8_STAGE(PG8_SA(1, 1), a1 + hstep, voffA);
            PG8_WAIT_V(8); PG8_WAIT_L(0); PG8_BAR; PG8_MMA(0, 0, At, B0); PG8_MMA(0, 1, At, B1); PG8_BAR; PG8_SCHED;
            PG8_LDA(At, 0, 1); PG8_STAGE(PG8_SB(0, 0), b2, voffB); PG8_STAGE(PG8_SB(0, 1), b2 + hstep, voffB); PG8_STAGE(PG8_SA(0, 0), a2, voffA);
            PG8_WAIT_V(8); PG8_WAIT_L(0); PG8_BAR; PG8_MMA(1, 0, At, B0); PG8_MMA(1, 1, At, B1); PG8_BAR; PG8_SCHED;
            PG8_LDB(B0, 1, 0); PG8_LDB(B1, 1, 1); PG8_SCHED; PG8_LDA(At, 1, 0); PG8_STAGE(PG8_SA(0, 1), a2 + hstep, voffA);
            PG8_WAIT_V(8); PG8_WAIT_L(0); PG8_BAR; PG8_MMA(0, 0, At, B0); PG8_MMA(0, 1, At, B1); PG8_BAR; PG8_SCHED;
            PG8_LDA(At, 1, 1); PG8_STAGE(PG8_SB(1, 0), b3, voffB); PG8_STAGE(PG8_SB(1, 1), b3 + hstep, voffB); PG8_STAGE(PG8_SA(1, 0), a3, voffA);
            PG8_WAIT_V(8); PG8_WAIT_L(0); PG8_BAR; PG8_MMA(1, 0, At, B0); PG8_MMA(1, 1, At, B1); PG8_BAR; PG8_SCHED;
            } else {
            PG8_LDB(B0, 0, 0); PG8_SCHED; PG8_LDA(At, 0, 0); PG8_STAGE(PG8_SA(1, 1), a1 + hstep, voffA);
            PG8_WAIT_L(8); PG8_BAR; PG8_WAIT_L(0); PG8_MMA(0, 0, At, B0); PG8_BAR; PG8_SCHED;
            PG8_LDB(B1, 0, 1); PG8_STAGE(PG8_SB(0, 0), b2, voffB);
            PG8_BAR; PG8_WAIT_L(0); PG8_MMA(0, 1, At, B1); PG8_BAR;
            PG8_LDA(At, 0, 1); PG8_STAGE(PG8_SA(0, 0), a2, voffA);
            PG8_BAR; PG8_WAIT_L(0); PG8_MMA(1, 0, At, B0); PG8_BAR; PG8_SCHED;
            PG8_STAGE(PG8_SB(0, 1), b2 + hstep, voffB);
            PG8_WAIT_V(6); PG8_BAR; PG8_MMA(1, 1, At, B1); PG8_BAR;
            PG8_LDB(B0, 1, 0); PG8_SCHED; PG8_LDA(At, 1, 0); PG8_STAGE(PG8_SA(0, 1), a2 + hstep, voffA);
            PG8_WAIT_L(8); PG8_BAR; PG8_WAIT_L(0); PG8_MMA(0, 0, At, B0); PG8_BAR; PG8_SCHED;
            PG8_LDB(B1, 1, 1); PG8_STAGE(PG8_SB(1, 0), b3, voffB);
            PG8_BAR; PG8_WAIT_L(0); PG8_MMA(0, 1, At, B1); PG8_BAR;
            PG8_LDA(At, 1, 1); PG8_STAGE(PG8_SA(1, 0), a3, voffA);
            PG8_BAR; PG8_WAIT_L(0); PG8_MMA(1, 0, At, B0); PG8_BAR; PG8_SCHED;
            PG8_STAGE(PG8_SB(1, 1), b3 + hstep, voffB);
            PG8_WAIT_V(6); PG8_BAR; PG8_MMA(1, 1, At, B1); PG8_BAR;
            }
        }
        if constexpr (ALIGN_EPI) { if (wr == 0) PG8_BAR; }
        if constexpr (!Epi::AFTER_DRAIN) { E(acc, cur, wr, wc, fr, fq); S.done(cur); }
        if (!has_next) break;
#pragma unroll
        for (int a = 0; a < 2; ++a)
#pragma unroll
            for (int b = 0; b < 2; ++b)
#pragma unroll
                for (int m = 0; m < 4; ++m)
#pragma unroll
                    for (int n = 0; n < 2; ++n) { const float z0_ = opaque_zero(); acc[a][b][m][n] = (f32x4){z0_, z0_, z0_, z0_}; }
        cur = nxt; cA = nA; cB = nB; ++ui;
        if constexpr (ALIGN_EPI) { if (wr == 1) PG8_BAR; }
    }
    PG8_WAIT_V(0);
    if constexpr (!ALIGN_EPI) { if (wr == 0) PG8_BAR; }
    PG8_BAR;
    if constexpr (Epi::AFTER_DRAIN) { E.fused(acc, cur, wr, wc, fr, fq, lds, wid, lane); S.done(cur); }
#undef PG8_SA
#undef PG8_SB
#undef PG8_STAGE
#undef PG8_LDA
#undef PG8_LDB
#undef PG8_MMA
#undef PG8_WAIT_V
#undef PG8_WAIT_L
#undef PG8_BAR
#undef PG8_SCHED
}
}

#define LAS __attribute__((address_space(3)))
#define GAS __attribute__((address_space(1)))
typedef unsigned short bf16_t;
typedef short bf16x8 __attribute__((ext_vector_type(8)));
typedef float f32x4 __attribute__((ext_vector_type(4)));
typedef float f32x2 __attribute__((ext_vector_type(2)));
typedef float f32x16 __attribute__((ext_vector_type(16)));
typedef unsigned u32x4 __attribute__((ext_vector_type(4)));
typedef unsigned u32x2 __attribute__((ext_vector_type(2)));
typedef const GAS float* gcf;
typedef GAS float* gf;
typedef const GAS bf16_t* gcb;
typedef GAS bf16_t* gb;

constexpr int DM = 1024, SEQ = 4096, NB = 8, CTXL = 256, DFF = 2816;
constexpr int MLAT = NB * SEQ;
constexpr int MTOT = MLAT + NB * CTXL;
constexpr int NMODC = 9 * DM;
constexpr float EPS = 1e-6f;
constexpr float LOG2E = 1.4426950408889634f;
constexpr float LAM_INIT = 0.35550906759096934f;

constexpr size_t MiB = 1u << 20;
constexpr size_t WS_MODS = 0, WS_TAB = 2 * MiB, WS_BAR = 3 * MiB, BAR_ZERO_BYTES = 16384, WS_W0 = 4 * MiB, WS_WSZ = 44 * MiB, WS_X = 92 * MiB, WS_HN = 228 * MiB, WS_S = 296 * MiB, WS_END = 636 * MiB;
constexpr size_t S_HH = 0, S_PART = 192 * MiB;
constexpr size_t S_A = 0, S_CQN = 102 * MiB, S_CKVN = 128 * MiB, S_KR = 146 * MiB, S_Q = 152 * MiB, S_KN = 0, S_VT_MLA = 256 * MiB;
constexpr size_t S_QK = 0, S_VT_DIFF = 136 * MiB, S_O2 = 204 * MiB, S_VT_SWA = 88 * MiB;
constexpr size_t OFF_WIN0 = 0, OFF_WOUT0 = 5767168, OFF_WIN1 = 8650752, OFF_WOUT1 = 14417920, OFF_MIX = 17301504;
constexpr size_t MLA_WA = 0, MLA_WQB = 786432, MLA_WKN = 1376256, MLA_WVT = 1638400, MLA_WO = 1900544;
constexpr size_t DIF_WQK = 0, DIF_WV = 2097152, DIF_WO = 3145728;
constexpr size_t SWA_WQK = 0, SWA_WV = 1310720, SWA_WO = 1572864;

constexpr int LDS_BYTES = 147456;

__device__ const float INVF[16] = {1.0f, 0.5623413324356079f, 0.3162277638912201f, 0.17782793939113617f, 0.10000000149011612f, 0.05623413249850273f, 0.03162277489900589f, 0.017782794311642647f,
                                   0.009999999776482582f, 0.005623413249850273f, 0.003162277629598975f, 0.0017782794311642647f, 0.0010000000474974513f, 0.000562341301701963f, 0.0003162277571391314f, 0.00017782794020604342f};

enum { OP_PRO = 0, OP_NORM, OP_FFN_IN, OP_FFN_OUT, OP_MLA_IN, OP_MLA_ROW, OP_PROJ, OP_ATT, OP_DIFF_ROW, OP_MIX_OUT, OP_FINAL };
#ifndef DUP_MASK
#define DUP_MASK 0
#endif
#ifndef DUP_SYNC
#define DUP_SYNC 0
#endif
#ifndef PROBE_SKIP_EPI
#define PROBE_SKIP_EPI 0
#endif
struct Prog { unsigned e[128]; int n; };
constexpr void prog_add(Prog& p, int op, int l, int s) {
    p.e[p.n++] = (unsigned)op | ((unsigned)l << 8) | ((unsigned)s << 16);
    if ((DUP_MASK >> op) & 1) p.e[p.n++] = (unsigned)op | ((unsigned)l << 8) | ((unsigned)(s | 0x80) << 16);
}
constexpr Prog make_prog() {
    Prog p{}; p.n = 0;
    prog_add(p, OP_PRO, 0, 0);
    for (int l = 0; l < 4; ++l) {
        const int kind = l % 3;
        prog_add(p, OP_NORM, l, 0); prog_add(p, OP_FFN_IN, l, 0); prog_add(p, OP_FFN_OUT, l, 0); prog_add(p, OP_NORM, l, 1);
        if (kind == 0) { prog_add(p, OP_MLA_IN, l, 0); prog_add(p, OP_MLA_ROW, l, 0); }
        prog_add(p, OP_PROJ, l, 0); prog_add(p, OP_ATT, l, 0);
        if (kind == 1) prog_add(p, OP_DIFF_ROW, l, 0);
        prog_add(p, OP_MIX_OUT, l, 0); prog_add(p, OP_NORM, l, 2); prog_add(p, OP_FFN_IN, l, 1); prog_add(p, OP_FFN_OUT, l, 1);
    }
    prog_add(p, OP_FINAL, 0, 0);
    return p;
}
constexpr Prog PROG_H = make_prog();
constexpr int NPHASE = PROG_H.n;
__device__ const Prog PROG_D = make_prog();

__device__ __forceinline__ unsigned pk2(float lo, float hi) { typedef __bf16 bf16x2_t __attribute__((ext_vector_type(2))); f32x2 v = {lo, hi}; bf16x2_t b = __builtin_convertvector(v, bf16x2_t); return __builtin_bit_cast(unsigned, b); }
__device__ __forceinline__ float wave_sum_l(float v, int lane) {
#pragma unroll
    for (int o = 1; o < 64; o <<= 1) v += __int_as_float(__builtin_amdgcn_ds_bpermute((lane ^ o) << 2, __float_as_int(v)));
    return v;
}
#define wave_sum(v) wave_sum_l((v), lane)
__device__ __forceinline__ float fast_exp2(float x) { return __builtin_amdgcn_exp2f(x); }
__device__ __forceinline__ float silu_fast(float x) { return x * __builtin_amdgcn_rcpf(1.0f + __builtin_amdgcn_exp2f(-x * LOG2E)); }
__device__ __forceinline__ float half_max(float m) { auto rr = __builtin_amdgcn_permlane32_swap(__float_as_uint(m), __float_as_uint(m), false, false); return fmaxf(__uint_as_float(rr[0]), __uint_as_float(rr[1])); }
__device__ __forceinline__ float half_sum(float m) { auto rr = __builtin_amdgcn_permlane32_swap(__float_as_uint(m), __float_as_uint(m), false, false); return __uint_as_float(rr[0]) + __uint_as_float(rr[1]); }

struct EpiStoreBf16 {
    static constexpr bool PERM = true, AFTER_DRAIN = false;
    gb O; int ldc;
    __device__ __forceinline__ void operator()(const f32x4 (&acc)[2][2][4][2], const pg8::Unit& u, int wr, int wc, int fr, int fq) const {
        const int row0 = u.pm * 256 + wr * 64 + fr, col0 = u.pn * 256 + wc * 32 + 8 * fq;
#pragma unroll
        for (int ai = 0; ai < 2; ++ai)
#pragma unroll
            for (int m = 0; m < 4; ++m) { gb rowp = O + (size_t)(row0 + ai * 128 + m * 16) * ldc + col0;
#pragma unroll
                for (int bj = 0; bj < 2; ++bj) { const f32x4 v0 = acc[ai][bj][m][0], v1 = acc[ai][bj][m][1];
                    u32x4 w; w.x = pk2(v0[0], v0[1]); w.y = pk2(v0[2], v0[3]); w.z = pk2(v1[0], v1[1]); w.w = pk2(v1[2], v1[3]);
                    *(GAS u32x4*)(rowp + bj * 128) = w; } }
    }
};
struct EpiSwiglu {
    static constexpr bool PERM = true, AFTER_DRAIN = false;
    gb O;
    __device__ __forceinline__ void operator()(const f32x4 (&acc)[2][2][4][2], const pg8::Unit& u, int wr, int wc, int fr, int fq) const {
        const int row0 = u.pm * 256 + wr * 64 + fr, col0 = u.pn * 128 + wc * 32 + 8 * fq;
#pragma unroll
        for (int ai = 0; ai < 2; ++ai)
#pragma unroll
            for (int m = 0; m < 4; ++m) { gb rowp = O + (size_t)(row0 + ai * 128 + m * 16) * DFF + col0;
                const f32x4 g0 = acc[ai][0][m][0], g1 = acc[ai][0][m][1], u0 = acc[ai][1][m][0], u1 = acc[ai][1][m][1];
                u32x4 w; w.x = pk2(silu_fast(g0[0]) * u0[0], silu_fast(g0[1]) * u0[1]); w.y = pk2(silu_fast(g0[2]) * u0[2], silu_fast(g0[3]) * u0[3]);
                w.z = pk2(silu_fast(g1[0]) * u1[0], silu_fast(g1[1]) * u1[1]); w.w = pk2(silu_fast(g1[2]) * u1[2], silu_fast(g1[3]) * u1[3]);
                *(GAS u32x4*)rowp = w; }
    }
};
struct EpiResid {
    static constexpr bool PERM = true, AFTER_DRAIN = false;
    gcf base_lat, base_ctx; gf X; gcf gate; unsigned gsc_bits;
    __device__ __forceinline__ void operator()(const f32x4 (&acc)[2][2][4][2], const pg8::Unit& u, int wr, int wc, int fr, int fq) const {
        if (PROBE_SKIP_EPI && gsc_bits == 0u) return;
        const int b = u.pm < 128 ? (u.pm >> 4) : 8;
        const int col0 = u.pn * 256 + wc * 32 + 8 * fq;
        gcf gp = gate + (size_t)b * NMODC + col0;
        f32x4 gv[2][2];
#pragma unroll
        for (int bj = 0; bj < 2; ++bj)
#pragma unroll
            for (int n = 0; n < 2; ++n) gv[bj][n] = *(const GAS f32x4*)(gp + bj * 128 + n * 4) * __uint_as_float(gsc_bits);
#pragma unroll
        for (int ai = 0; ai < 2; ++ai)
#pragma unroll
            for (int m = 0; m < 4; ++m) { const int row = u.pm * 256 + ai * 128 + wr * 64 + m * 16 + fr;
                gcf bp = (row < MLAT ? base_lat + (size_t)row * DM : base_ctx + (size_t)(row - MLAT) * DM) + col0;
                gf xp = X + (size_t)row * DM + col0;
#pragma unroll
                for (int bj = 0; bj < 2; ++bj)
#pragma unroll
                    for (int n = 0; n < 2; ++n) {
                        if (u.split) { gf part = (gf)((GAS unsigned char*)X + (WS_S + S_PART - WS_X)); *(GAS f32x4*)(part + ((size_t)(u.split - 1) * 2048 + (row - MLAT)) * DM + col0 + bj * 128 + n * 4) = acc[ai][bj][m][n]; }
                        else { const f32x4 bs = *(const GAS f32x4*)(bp + bj * 128 + n * 4); *(GAS f32x4*)(xp + bj * 128 + n * 4) = bs + gv[bj][n] * acc[ai][bj][m][n]; } } }
    }
};
struct EpiF32 {
    static constexpr bool PERM = false, AFTER_DRAIN = false;
    gf O; int ldc;
    __device__ __forceinline__ void operator()(const f32x4 (&acc)[2][2][4][2], const pg8::Unit& u, int wr, int wc, int fr, int fq) const {
        const int col0 = u.pn * 256 + wc * 32 + 4 * fq;
#pragma unroll
        for (int ai = 0; ai < 2; ++ai)
#pragma unroll
            for (int m = 0; m < 4; ++m) { gf op = O + (size_t)(u.pm * 256 + ai * 128 + wr * 64 + m * 16 + fr) * ldc + col0;
#pragma unroll
                for (int bj = 0; bj < 2; ++bj)
#pragma unroll
                    for (int n = 0; n < 2; ++n) *(GAS f32x4*)(op + bj * 128 + n * 16) = acc[ai][bj][m][n]; }
    }
};
struct EpiRope {
    static constexpr bool PERM = false, AFTER_DRAIN = false;
    gb O; int ldc, period, rope_start, nq; float qscale; gcf tab;
    __device__ __forceinline__ void operator()(const f32x4 (&acc)[2][2][4][2], const pg8::Unit& u, int wr, int wc, int fr, int fq) const {
        const bool lat = u.pm < 128;
#pragma unroll
        for (int bj = 0; bj < 2; ++bj) {
            const int colg = u.pn * 256 + bj * 128 + wc * 32, cm = colg % period;
            const bool rope = lat && (cm >= rope_start);
            const int axis = ((cm - rope_start) >> 5) & 1;
            const float sc = colg < nq ? qscale : 1.0f;
#pragma unroll
            for (int ai = 0; ai < 2; ++ai)
#pragma unroll
                for (int m = 0; m < 4; ++m) { const int row = u.pm * 256 + ai * 128 + wr * 64 + m * 16 + fr;
                    f32x4 x1 = acc[ai][bj][m][0], x2 = acc[ai][bj][m][1];
                    if (rope) { const int t = row & (SEQ - 1), pos = axis ? (t & 63) : (t >> 6);
                        const GAS f32x4* tp = (const GAS f32x4*)(tab + (pos * 16 + 4 * fq) * 2);
                        const f32x4 t0 = tp[0], t1 = tp[1];
                        const f32x4 c = {t0[0], t0[2], t1[0], t1[2]}, s = {t0[1], t0[3], t1[1], t1[3]};
                        const f32x4 o1 = x1 * c - x2 * s, o2 = x2 * c + x1 * s; x1 = o1; x2 = o2; }
                    x1 = x1 * sc; x2 = x2 * sc;
                    gb op = O + (size_t)row * ldc + colg + 4 * fq;
                    u32x2 w1, w2; w1.x = pk2(x1[0], x1[1]); w1.y = pk2(x1[2], x1[3]); w2.x = pk2(x2[0], x2[1]); w2.y = pk2(x2[2], x2[3]);
                    *(GAS u32x2*)op = w1; *(GAS u32x2*)(op + 16) = w2;
                    asm volatile("" ::: "memory"); }
        }
    }
};

template <class Epi> __device__ __forceinline__ void run_gemm(LAS unsigned char* lds, int G_, int bx_, gcb A, gcb Bt, int M, int N, int K, const Epi& E, bool split = false) {
    pg8::Gemm g{(const bf16_t*)A, (const bf16_t*)Bt, M, N, K}; pg8::StaticOrder S; S.init(M, N, G_, bx_, K / 64, split);
    pg8::gemm_phase<Epi, pg8::StaticOrder, true, true>(lds, g, S, E);
}

__device__ __forceinline__ unsigned f2bf(float f) { unsigned u = __builtin_bit_cast(unsigned, f); return (u + 0x7fffu + ((u >> 16) & 1u)) >> 16; }
__device__ __forceinline__ unsigned pk2s(float lo, float hi) { return f2bf(lo) | (f2bf(hi) << 16); }
__device__ __forceinline__ void conv_item(gcf W, int K, int N, int k0, int n0, gb drow, LAS float* scr, int lane) {
#pragma unroll 8
    for (int i = 0; i < 32; ++i) { const int kk = 2 * i + (lane >> 5); scr[kk * 33 + (lane & 31)] = W[(size_t)(k0 + kk) * N + n0 + (lane & 31)]; }
    asm volatile("s_waitcnt lgkmcnt(0)" ::: "memory");
    const int c = lane & 7;
#pragma unroll
    for (int j = 0; j < 4; ++j) { const int n = (lane >> 3) + 8 * j; const LAS float* s = scr + (8 * c) * 33 + n;
        u32x4 o; o.x = pk2s(s[0 * 33], s[1 * 33]); o.y = pk2s(s[2 * 33], s[3 * 33]); o.z = pk2s(s[4 * 33], s[5 * 33]); o.w = pk2s(s[6 * 33], s[7 * 33]);
        *(GAS u32x4*)(drow + (size_t)n * K + k0 + 8 * c) = o; }
    asm volatile("s_waitcnt lgkmcnt(0)" ::: "memory");
}
__device__ __forceinline__ bool conv_job(int& r, gcf W, int K, int N, int kind, gb d1, gb d2, int S, LAS float* scr, int lane) {
    const int nblk = N / 32, items = (K / 64) * nblk;
    if (r >= items) { r -= items; return false; }
    const int kb = r / nblk, nb = r % nblk, k0 = 64 * kb, n0 = 32 * nb;
    gb drow;
    if (kind == 0) drow = d1 + (size_t)n0 * K;
    else if (kind == 1) { const int nn = n0 < DFF ? n0 : n0 - DFF; drow = d1 + (size_t)(256 * (nn / 128) + (n0 < DFF ? 0 : 128) + (nn % 128)) * K; }
    else if (kind == 2) drow = n0 < S ? d1 + (size_t)n0 * K : d2 + (size_t)(n0 - S) * K;
    else { const int h = n0 / 256, off = n0 % 256; drow = off < 128 ? d1 + (size_t)(h * 128 + off) * K : d2 + (size_t)(h * 128 + off - 128) * K; }
    conv_item(W, K, N, k0, n0, drow, scr, lane);
    return true;
}

struct Ptrs {
    gcf x, c, ctx, c_ctx, w_mod, b_mod, g_norm, w_ffn_in, w_ffn_out, a_w_in, a_g_q, a_g_kv, a_w_qb, a_w_kvb, a_w_o, b_w_qkv, b_lambda, b_g_sub, b_w_o, c_w_qkv, c_sink, c_w_o, g_final;
    gf out; GAS unsigned char* ws; int bx, G;
};

__device__ __forceinline__ void conv_layer(const Ptrs& P, int l, LAS unsigned char* lds, int tid, int wid, int lane) {
    gb Wd = (gb)(P.ws + WS_W0 + (size_t)(l & 1) * WS_WSZ);
    LAS float* scr = (LAS float*)(lds + wid * 16384);
    const int gw = P.bx * 8 + wid, NGW = P.G * 8;
    const int kind = l % 3, j = l / 3;
    gcf fin0 = P.w_ffn_in + (size_t)(l * 2 + 0) * DM * 2 * DFF, fin1 = P.w_ffn_in + (size_t)(l * 2 + 1) * DM * 2 * DFF;
    gcf fo0 = P.w_ffn_out + (size_t)(l * 2 + 0) * DFF * DM, fo1 = P.w_ffn_out + (size_t)(l * 2 + 1) * DFF * DM;
    gb mix = Wd + OFF_MIX;
    for (int it = gw; it < 16384; it += NGW) {
        int r = it;
        if (conv_job(r, fin0, DM, 2 * DFF, 1, Wd + OFF_WIN0, Wd, 0, scr, lane)) continue;
        if (conv_job(r, fo0, DFF, DM, 0, Wd + OFF_WOUT0, Wd, 0, scr, lane)) continue;
        if (conv_job(r, fin1, DM, 2 * DFF, 1, Wd + OFF_WIN1, Wd, 0, scr, lane)) continue;
        if (conv_job(r, fo1, DFF, DM, 0, Wd + OFF_WOUT1, Wd, 0, scr, lane)) continue;
        if (kind == 0) {
            if (conv_job(r, P.a_w_in + (size_t)j * DM * 704, DM, 704, 0, mix + MLA_WA, mix, 0, scr, lane)) continue;
            if (conv_job(r, P.a_w_qb + (size_t)j * 384 * 1536, 384, 1536, 0, mix + MLA_WQB, mix, 0, scr, lane)) continue;
            if (conv_job(r, P.a_w_kvb + (size_t)j * 256 * 2048, 256, 2048, 3, mix + MLA_WKN, mix + MLA_WVT, 0, scr, lane)) continue;
            if (conv_job(r, P.a_w_o + (size_t)j * DM * DM, DM, DM, 0, mix + MLA_WO, mix, 0, scr, lane)) continue;
        } else if (kind == 1) {
            if (conv_job(r, P.b_w_qkv, DM, 3072, 2, mix + DIF_WQK, mix + DIF_WV, 2048, scr, lane)) continue;
            if (conv_job(r, P.b_w_o, DM, DM, 0, mix + DIF_WO, mix, 0, scr, lane)) continue;
        } else {
            if (conv_job(r, P.c_w_qkv, DM, 1536, 2, mix + SWA_WQK, mix + SWA_WV, 1280, scr, lane)) continue;
            if (conv_job(r, P.c_w_o, DM, DM, 0, mix + SWA_WO, mix, 0, scr, lane)) continue;
        }
        break;
    }
    if (kind == 0) {
        const int gt = P.bx * 512 + tid, NT = P.G * 512;
        for (int i = gt; i < 8192; i += NT) { const unsigned zz = __float_as_uint(opaque_zero()); *(GAS u32x4*)(mix + MLA_WA + (size_t)704 * DM + (size_t)i * 8) = (u32x4){zz, zz, zz, zz}; }
    }
}

__device__ __forceinline__ void sincos_d(double a, float& c, float& s) {
    const double TWO_PI = 6.283185307179586476925286766559;
    const double k = __builtin_rint(a / TWO_PI); const double r = a - k * TWO_PI, r2 = r * r;
    double ts = r, ss = r, tc = 1.0, cc = 1.0;
#pragma unroll
    for (int i = 1; i <= 14; ++i) { tc *= -r2 / (double)((2 * i - 1) * (2 * i)); cc += tc; ts *= -r2 / (double)((2 * i) * (2 * i + 1)); ss += ts; }
    c = (float)cc; s = (float)ss;
}
__device__ __forceinline__ void prologue(const Ptrs& P, LAS unsigned char* lds, int tid, int wid, int lane) {
    if (P.bx == 0) {
        gf tab = (gf)(P.ws + WS_TAB);
        for (int idx = tid; idx < 1024; idx += 512) { const int pos = idx >> 4, i = idx & 15; const float ang = (float)pos * INVF[i]; float c, s; sincos_d((double)ang, c, s); tab[idx * 2] = c; tab[idx * 2 + 1] = s; }
    }
    LAS float* sS = (LAS float*)lds;
    LAS float* red = (LAS float*)(lds + 49152);
    for (int idx = tid; idx < 9 * DM; idx += 512) { const int b = idx >> 10, k = idx & 1023; const float v = b < 8 ? P.c[b * DM + k] : P.c_ctx[k]; sS[k * 12 + b] = v / (1.0f + __expf(-v)); }
    __syncthreads();
    gf mods = (gf)(P.ws + WS_MODS);
    for (int u = P.bx; u < 4 * 72; u += P.G) {
        const int l = u / 72, n0 = (u % 72) * 128;
        gcf wp = P.w_mod + ((size_t)l * DM + wid * 128) * NMODC + n0 + 2 * lane;
        float acc[9][2];
#pragma unroll
        for (int b = 0; b < 9; ++b) { acc[b][0] = 0.f; acc[b][1] = 0.f; }
#pragma unroll 8
        for (int k = 0; k < 128; ++k) {
            const f32x2 w = *(const GAS f32x2*)(wp + (size_t)k * NMODC);
            const LAS f32x4* sp = (const LAS f32x4*)(sS + (wid * 128 + k) * 12);
            const f32x4 s0 = sp[0], s1 = sp[1], s2 = sp[2];
            acc[0][0] += s0[0] * w[0]; acc[0][1] += s0[0] * w[1]; acc[1][0] += s0[1] * w[0]; acc[1][1] += s0[1] * w[1];
            acc[2][0] += s0[2] * w[0]; acc[2][1] += s0[2] * w[1]; acc[3][0] += s0[3] * w[0]; acc[3][1] += s0[3] * w[1];
            acc[4][0] += s1[0] * w[0]; acc[4][1] += s1[0] * w[1]; acc[5][0] += s1[1] * w[0]; acc[5][1] += s1[1] * w[1];
            acc[6][0] += s1[2] * w[0]; acc[6][1] += s1[2] * w[1]; acc[7][0] += s1[3] * w[0]; acc[7][1] += s1[3] * w[1];
            acc[8][0] += s2[0] * w[0]; acc[8][1] += s2[0] * w[1];
        }
#pragma unroll
        for (int b = 0; b < 9; ++b) { red[(wid * 9 + b) * 128 + 2 * lane] = acc[b][0]; red[(wid * 9 + b) * 128 + 2 * lane + 1] = acc[b][1]; }
        __syncthreads();
        for (int idx = tid; idx < 9 * 128; idx += 512) { const int b = idx >> 7, n = idx & 127; float s = 0.f;
#pragma unroll
            for (int w = 0; w < 8; ++w) s += red[(w * 9 + b) * 128 + n];
            mods[((size_t)l * 9 + b) * NMODC + n0 + n] = s + P.b_mod[(size_t)l * NMODC + n0 + n]; }
        __syncthreads();
    }
    __syncthreads();
    conv_layer(P, 0, lds, tid, wid, lane);
}

__device__ __forceinline__ void norm_phase(const Ptrs& P, int l, int which, int wid, int lane) {
    const bool from_in = (l == 0 && which == 0);
    gcf X = (gcf)(P.ws + WS_X);
    gcf slat = from_in ? P.x : X, sctx = from_in ? P.ctx : X + (size_t)MLAT * DM;
    gb Hn = (gb)(P.ws + WS_HN);
    gcf g = P.g_norm + (size_t)(l * 3 + which) * DM;
    gcf mods = (gcf)(P.ws + WS_MODS) + (size_t)l * 9 * NMODC + (size_t)(3 * which) * DM;
    const int M = (l == 3 && which == 2) ? MLAT : MTOT;
    const int gw = P.bx * 8 + wid, NGW = P.G * 8;
    const bool pend = !from_in && which != 2;
    const int pl = which == 0 ? l - 1 : l, pidx = which == 0 ? 8 : (which == 1 ? 2 : 5);
    const float pgsc = which == 2 ? 1.0f : 0.5f;
    gcf pgate = (gcf)(P.ws + WS_MODS) + ((size_t)(pend ? pl : 0) * 9 + 8) * NMODC + (size_t)pidx * DM;
    gcf part = (gcf)(P.ws + WS_S + S_PART);
    f32x4 gg[4];
#pragma unroll
    for (int j = 0; j < 4; ++j) gg[j] = ((const GAS f32x4*)g)[lane + 64 * j];
    f32x4 vn[4];
#define NORM_XR(r) ((const GAS f32x4*)((r) < MLAT ? slat + (size_t)(r) * DM : sctx + (size_t)((r) - MLAT) * DM) + lane)
    if (gw < M) { const GAS f32x4* xr0 = NORM_XR(gw);
#pragma unroll
        for (int j = 0; j < 4; ++j) vn[j] = xr0[64 * j]; }
    int bcur = -1; f32x4 shv[4], scv[4];
#pragma unroll
    for (int j = 0; j < 4; ++j) { shv[j] = (f32x4){0.f, 0.f, 0.f, 0.f}; scv[j] = (f32x4){0.f, 0.f, 0.f, 0.f}; }
    for (int row = gw; row < M; row += NGW) {
        const int b = row < MLAT ? (row >> 12) : 8;
        if (b != bcur) { bcur = b;
#pragma unroll
            for (int j = 0; j < 4; ++j) { shv[j] = ((const GAS f32x4*)(mods + (size_t)b * NMODC))[lane + 64 * j]; scv[j] = ((const GAS f32x4*)(mods + (size_t)b * NMODC + DM))[lane + 64 * j] + 1.0f; } }
        f32x4 v[4]; float s = 0.f;
#pragma unroll
        for (int j = 0; j < 4; ++j) v[j] = vn[j];
        if (row + NGW < M) { const GAS f32x4* xr1 = NORM_XR(row + NGW);
#pragma unroll
            for (int j = 0; j < 4; ++j) vn[j] = xr1[64 * j]; }
#pragma unroll
        for (int j = 0; j < 4; ++j) s += (v[j][0] * v[j][0] + v[j][1] * v[j][1]) + (v[j][2] * v[j][2] + v[j][3] * v[j][3]);
        if (from_in) { GAS f32x4* xo = (GAS f32x4*)(P.ws + WS_X + (size_t)row * DM * 4) + lane;
#pragma unroll
            for (int j = 0; j < 4; ++j) xo[64 * j] = v[j]; }
        else if (pend && row >= MLAT) { GAS f32x4* xo = (GAS f32x4*)(P.ws + WS_X + (size_t)row * DM * 4) + lane; s = 0.f;
#pragma unroll
            for (int j = 0; j < 4; ++j) { f32x4 a = {0.f, 0.f, 0.f, 0.f};
#pragma unroll
                for (int p = 0; p < 8; ++p) a += ((const GAS f32x4*)(part + ((size_t)p * 2048 + (row - MLAT)) * DM))[lane + 64 * j];
                v[j] = v[j] + (((const GAS f32x4*)pgate)[lane + 64 * j] * pgsc) * a; xo[64 * j] = v[j];
                s += (v[j][0] * v[j][0] + v[j][1] * v[j][1]) + (v[j][2] * v[j][2] + v[j][3] * v[j][3]); } }
        const float rstd = 1.0f / sqrtf(wave_sum(s) * (1.0f / DM) + EPS);
        GAS u32x2* o8 = (GAS u32x2*)(Hn + (size_t)row * DM) + lane;
#pragma unroll
        for (int j = 0; j < 4; ++j) { const f32x4 hv = (v[j] * rstd) * gg[j] * scv[j] + shv[j];
            u32x2 w; w.x = pk2(hv[0], hv[1]); w.y = pk2(hv[2], hv[3]); o8[64 * j] = w; }
    }
#undef NORM_XR
}
__device__ __forceinline__ void mla_row_phase(const Ptrs& P, int l, int wid, int lane) {
    const int j = l / 3;
    gcf A = (gcf)(P.ws + WS_S + S_A); gb cqn = (gb)(P.ws + WS_S + S_CQN), ckvn = (gb)(P.ws + WS_S + S_CKVN), kr = (gb)(P.ws + WS_S + S_KR);
    gcf gq = P.a_g_q + (size_t)j * 384, gkv = P.a_g_kv + (size_t)j * 256; gcf tab = (gcf)(P.ws + WS_TAB);
    const int gw = P.bx * 8 + wid, NGW = P.G * 8;
    for (int row = gw; row < MTOT; row += NGW) {
        gcf a = A + (size_t)row * 768;
        f32x2 q[3]; float s = 0.f;
#pragma unroll
        for (int i = 0; i < 3; ++i) { q[i] = *(const GAS f32x2*)(a + 2 * lane + 128 * i); s += q[i][0] * q[i][0] + q[i][1] * q[i][1]; }
        const float rq = 1.0f / sqrtf(wave_sum(s) * (1.0f / 384.0f) + EPS);
#pragma unroll
        for (int i = 0; i < 3; ++i) { const f32x2 g2 = *(const GAS f32x2*)(gq + 2 * lane + 128 * i); *(GAS unsigned*)(cqn + (size_t)row * 384 + 2 * lane + 128 * i) = pk2(q[i][0] * rq * g2[0], q[i][1] * rq * g2[1]); }
        const f32x4 kv = *(const GAS f32x4*)(a + 384 + 4 * lane);
        const float rk = 1.0f / sqrtf(wave_sum((kv[0] * kv[0] + kv[1] * kv[1]) + (kv[2] * kv[2] + kv[3] * kv[3])) * (1.0f / 256.0f) + EPS);
        { const f32x4 g4 = *(const GAS f32x4*)(gkv + 4 * lane); u32x2 w; w.x = pk2(kv[0] * rk * g4[0], kv[1] * rk * g4[1]); w.y = pk2(kv[2] * rk * g4[2], kv[3] * rk * g4[3]); *(GAS u32x2*)(ckvn + (size_t)row * 256 + 4 * lane) = w; }
        const float mine = a[640 + lane]; const float other = __int_as_float(__builtin_amdgcn_ds_bpermute((lane ^ 16) << 2, __float_as_int(mine)));
        float outv = mine;
        if (row < MLAT) { const int t = row & (SEQ - 1), axis = lane >> 5, pos = axis ? (t & 63) : (t >> 6), i = lane & 15;
            const float c = tab[(pos * 16 + i) * 2], sn = tab[(pos * 16 + i) * 2 + 1];
            outv = (lane & 16) ? (mine * c + other * sn) : (mine * c - other * sn); }
        kr[(size_t)row * 64 + lane] = (bf16_t)f2bf(outv);
    }
}
__device__ __forceinline__ void diff_row_phase(const Ptrs& P, int wid, int lane) {
    gcb O2 = (gcb)(P.ws + WS_S + S_O2); gb On = (gb)(P.ws + WS_HN);
    gcf lp = P.b_lambda;
    const float lam = __expf(wave_sum(lp[lane] * lp[64 + lane])) - __expf(wave_sum(lp[128 + lane] * lp[192 + lane])) + LAM_INIT;
    const f32x2 g2 = *(const GAS f32x2*)(P.b_g_sub + 2 * lane);
    const int gw = P.bx * 8 + wid, NGW = P.G * 8;
    for (int row = gw; row < MTOT; row += NGW) {
        gcb o = O2 + (size_t)row * 2048 + 2 * lane;
#pragma unroll
        for (int h = 0; h < 8; ++h) {
            const unsigned a = *(const GAS unsigned*)(o + h * 256), b = *(const GAS unsigned*)(o + h * 256 + 128);
            const float d0 = __uint_as_float(a << 16) - lam * __uint_as_float(b << 16), d1 = __uint_as_float(a & 0xffff0000u) - lam * __uint_as_float(b & 0xffff0000u);
            const float r = 1.0f / sqrtf(wave_sum(d0 * d0 + d1 * d1) * (1.0f / 128.0f) + EPS) * (1.0f - LAM_INIT);
            *(GAS unsigned*)(On + (size_t)row * DM + h * 128 + 2 * lane) = pk2(d0 * r * g2[0], d1 * r * g2[1]);
        }
    }
}
__device__ __forceinline__ void final_phase(const Ptrs& P, int wid, int lane) {
    gcf X = (gcf)(P.ws + WS_X);
    const int gw = P.bx * 8 + wid, NGW = P.G * 8;
    f32x4 gg[4];
#pragma unroll
    for (int j = 0; j < 4; ++j) gg[j] = ((const GAS f32x4*)P.g_final)[lane + 64 * j];
    f32x4 vn[4];
    if (gw < MLAT) { const GAS f32x4* xr0 = (const GAS f32x4*)(X + (size_t)gw * DM) + lane;
#pragma unroll
        for (int j = 0; j < 4; ++j) vn[j] = xr0[64 * j]; }
    for (int row = gw; row < MLAT; row += NGW) {
        f32x4 v[4]; float s = 0.f;
#pragma unroll
        for (int j = 0; j < 4; ++j) v[j] = vn[j];
        if (row + NGW < MLAT) { const GAS f32x4* xr1 = (const GAS f32x4*)(X + (size_t)(row + NGW) * DM) + lane;
#pragma unroll
            for (int j = 0; j < 4; ++j) vn[j] = xr1[64 * j]; }
#pragma unroll
        for (int j = 0; j < 4; ++j) s += (v[j][0] * v[j][0] + v[j][1] * v[j][1]) + (v[j][2] * v[j][2] + v[j][3] * v[j][3]);
        const float rstd = 1.0f / sqrtf(wave_sum(s) * (1.0f / DM) + EPS);
        GAS f32x4* op = (GAS f32x4*)(P.out + (size_t)row * DM) + lane;
#pragma unroll
        for (int j = 0; j < 4; ++j) op[64 * j] = (v[j] * rstd) * gg[j];
    }
}

template <int DQK, int DV, bool MLA, bool WINDOW, bool SINK>
__device__ __forceinline__ void attn_phase(LAS unsigned char* lds, gcb Q, int ldq, gcb K, int ldk, gcb Kr, gcb Vt, gb O, int ldo, int nheads, int kdiv, int vdiv, gcf sink, bool with_ctx_q, int vcu, int G) {
    constexpr int KCH = DQK / 8, KCHP = KCH + 1, KSTR = KCHP * 16, VCHP = 9, VSTR = VCHP * 16, KBUF = 64 * KSTR, VBUF = DV * VSTR;
    constexpr int KINST = KCHP, VINST = (DV * VCHP) / 64;
    constexpr int NDC = DQK / 16, NDVB = DV / 32, NKI = (KINST + 7) / 8, NVI = (VINST + 7) / 8;
    constexpr int NDMA = KINST / 8 + VINST / 8;
    LAS unsigned char* ldsK = lds; LAS unsigned char* ldsV = lds + 3 * KBUF;
    static_assert(3 * (KBUF + VBUF) <= 140 * 1024, "attention LDS ring");
    int tid_ = threadIdx.x; asm volatile("" : "+v"(tid_));
    const int tid = tid_, lane = tid & 63, r32 = lane & 31, hi = lane >> 5, wid = __builtin_amdgcn_readfirstlane(tid >> 6);
    const int nlat = NB * nheads * 16, nunits = nlat + (with_ctx_q ? NB * nheads : 0);
    const int pr = (r32 & 0x13) | ((r32 & 4) << 1) | ((r32 & 8) >> 1);
    int kc[NKI], ks[NKI], kh[NKI], vc[NVI];
#pragma unroll
    for (int i = 0; i < NKI; ++i) { const int q = (wid + 8 * i) * 64 + lane, row = q / KCHP, cp = q % KCHP, c = cp < KCH ? cp : 0;
        if (MLA) { if (c < 16) { kc[i] = row * 2048 + c * 16; ks[i] = 2048; kh[i] = 2; } else { kc[i] = (int)((const GAS unsigned char*)Kr - (const GAS unsigned char*)K) + row * 128 + (c - 16) * 16; ks[i] = 128; kh[i] = 0; } }
        else { kc[i] = row * ldk * 2 + c * 16; ks[i] = ldk * 2; kh[i] = 2; } }
#pragma unroll
    for (int i = 0; i < NVI; ++i) { const int q = (wid + 8 * i) * 64 + lane, dv = q / VCHP, cp = q % VCHP, c = cp < 8 ? cp : 0; vc[i] = dv * (MTOT * 2) + c * 16; }
    for (int u = vcu; u < nunits; u += G) {
        int bh, qblk; if (u < nlat) { bh = u >> 4; qblk = u & 15; } else { bh = u - nlat; qblk = 16; }
        const int head = bh % nheads, b = bh / nheads;
        const bool isctx = (qblk == 16);
        const int qrow0 = isctx ? MLAT + b * CTXL : b * SEQ + qblk * 256;
        int lt0 = 0, lt1 = isctx ? 0 : 64;
        if (WINDOW && !isctx) { int lo = qblk * 256 - 128; if (lo < 0) lo = 0; int hh = qblk * 256 + 384; if (hh > SEQ) hh = SEQ; lt0 = lo >> 6; lt1 = hh >> 6; }
        const int NT = 4 + (lt1 - lt0);
        const int kcol = (head / kdiv) * (MLA ? 128 : 64);
        const size_t vrow0 = (size_t)(head / vdiv) * DV;
        bf16x8 qf[NDC];
        { gcb qp = Q + (size_t)(qrow0 + wid * 32 + r32) * ldq + head * DQK + hi * 8;
#pragma unroll
          for (int dc = 0; dc < NDC; ++dc) qf[dc] = *(const GAS bf16x8*)(qp + dc * 16); }
        float m_run = -1e30f, l_run = 0.f;
        if (SINK) { m_run = sink[head] * LOG2E; l_run = hi == 0 ? 1.0f : 0.0f; }
        f32x16 o[NDVB]; const float zatt = opaque_zero();
#pragma unroll
        for (int d = 0; d < NDVB; ++d)
#pragma unroll
            for (int r = 0; r < 16; ++r) o[d][r] = zatt;
#define ATT_DMA(t, bf) do { const int t_ = (t), bf_ = (bf); const int krow_ = t_ < 4 ? MLAT + b * CTXL + 64 * t_ : b * SEQ + 64 * (lt0 + t_ - 4); \
        _Pragma("unroll") for (int i = 0; i < NKI; ++i) if (wid + 8 * i < KINST) { \
            const unsigned off = (unsigned)(kc[i] + kh[i] * kcol + krow_ * ks[i]); \
            __builtin_amdgcn_global_load_lds((const GAS unsigned*)((const GAS unsigned char*)K + off), (LAS unsigned*)(ldsK + bf_ * KBUF + (wid + 8 * i) * 1024), 16, 0, 0); } \
        _Pragma("unroll") for (int i = 0; i < NVI; ++i) if (wid + 8 * i < VINST) { \
            __builtin_amdgcn_global_load_lds((const GAS unsigned*)((const GAS unsigned char*)(Vt + vrow0 * MTOT + krow_) + (unsigned)vc[i]), (LAS unsigned*)(ldsV + bf_ * VBUF + (wid + 8 * i) * 1024), 16, 0, 0); } } while (0)
#define ATT_WAITBAR(N) asm volatile("s_waitcnt vmcnt(%0) lgkmcnt(0)\n\ts_barrier" :: "n"(N) : "memory")
#define ATT_QK(d0, d1, bf_, t_) do { \
            { f32x16 e0_, e1_;     \
            _Pragma("unroll") for (int r = 0; r < 16; ++r) { d0[r] = 0.f; d1[r] = 0.f; e0_[r] = 0.f; e1_[r] = 0.f; } \
            { const LAS unsigned char* kb0 = ldsK + (bf_) * KBUF + pr * KSTR + hi * 16; const LAS unsigned char* kb1 = kb0 + 32 * KSTR; \
              _Pragma("unroll") for (int dc = 0; dc < NDC; dc += 2) { \
                  const bf16x8 k0 = *(const LAS bf16x8*)(kb0 + dc * 32), k1 = *(const LAS bf16x8*)(kb1 + dc * 32), k2 = *(const LAS bf16x8*)(kb0 + dc * 32 + 32), k3 = *(const LAS bf16x8*)(kb1 + dc * 32 + 32); \
                  d0 = __builtin_amdgcn_mfma_f32_32x32x16_bf16(k0, qf[dc], d0, 0, 0, 0); d1 = __builtin_amdgcn_mfma_f32_32x32x16_bf16(k1, qf[dc], d1, 0, 0, 0); \
                  e0_ = __builtin_amdgcn_mfma_f32_32x32x16_bf16(k2, qf[dc + 1], e0_, 0, 0, 0); e1_ = __builtin_amdgcn_mfma_f32_32x32x16_bf16(k3, qf[dc + 1], e1_, 0, 0, 0); } } \
            _Pragma("unroll") for (int r = 0; r < 16; ++r) { d0[r] += e0_[r]; d1[r] += e1_[r]; } } \
            if (WINDOW && (t_) >= 4) { const int kbase = 64 * (lt0 + (t_) - 4) + 8 * hi - (qblk * 256 + wid * 32 + r32); \
                _Pragma("unroll") for (int r = 0; r < 16; ++r) { const int e0 = kbase + 16 * (r >> 3) + (r & 7), e1 = e0 + 32; \
                    if (e0 > 128 || e0 < -128) d0[r] = -1e30f; if (e1 > 128 || e1 < -128) d1[r] = -1e30f; } } } while (0)
        ATT_DMA(0, 0); ATT_DMA(1, 1);
        ATT_WAITBAR(0);
        int buf = 0, buf1 = 1, buf2 = 2;
        constexpr bool PIPE = false;
        f32x16 s0, s1;
        if (PIPE) ATT_QK(s0, s1, 0, 0);
#pragma unroll 1
        for (int t = 0; t < NT; ++t) {
            if (t + 2 < NT) ATT_DMA(t + 2, buf2);
            f32x16 n0, n1;
            if (PIPE) ATT_QK(n0, n1, buf1, t + 1);
            else ATT_QK(s0, s1, buf, t);
            float mxa = fmaxf(s0[0], s1[0]), mxb = fmaxf(s0[1], s1[1]), mxc = fmaxf(s0[2], s1[2]), mxd = fmaxf(s0[3], s1[3]);
#pragma unroll
            for (int r = 4; r < 16; r += 4) { mxa = fmaxf(mxa, fmaxf(s0[r], s1[r])); mxb = fmaxf(mxb, fmaxf(s0[r + 1], s1[r + 1])); mxc = fmaxf(mxc, fmaxf(s0[r + 2], s1[r + 2])); mxd = fmaxf(mxd, fmaxf(s0[r + 3], s1[r + 3])); }
            float mx = half_max(fmaxf(fmaxf(mxa, mxb), fmaxf(mxc, mxd)));
            if (__builtin_amdgcn_ballot_w64(mx - m_run > 8.0f) != 0ull) {
                const float m_new = fmaxf(m_run, mx), alpha = fast_exp2(m_run - m_new); m_run = m_new; l_run *= alpha;
#pragma unroll
                for (int d = 0; d < NDVB; ++d)
#pragma unroll
                    for (int r = 0; r < 16; ++r) o[d][r] *= alpha;
            }
            float lsa = 0.f, lsb = 0.f, lsc = 0.f, lsd = 0.f;
#pragma unroll
            for (int r = 0; r < 16; r += 2) { s0[r] = fast_exp2(s0[r] - m_run); s1[r] = fast_exp2(s1[r] - m_run); s0[r + 1] = fast_exp2(s0[r + 1] - m_run); s1[r + 1] = fast_exp2(s1[r + 1] - m_run);
                lsa += s0[r]; lsb += s1[r]; lsc += s0[r + 1]; lsd += s1[r + 1]; }
            l_run += (lsa + lsb) + (lsc + lsd);
            bf16x8 pf[4];
            { u32x4 w;
              w.x = pk2(s0[0], s0[1]); w.y = pk2(s0[2], s0[3]); w.z = pk2(s0[4], s0[5]); w.w = pk2(s0[6], s0[7]); pf[0] = __builtin_bit_cast(bf16x8, w);
              w.x = pk2(s0[8], s0[9]); w.y = pk2(s0[10], s0[11]); w.z = pk2(s0[12], s0[13]); w.w = pk2(s0[14], s0[15]); pf[1] = __builtin_bit_cast(bf16x8, w);
              w.x = pk2(s1[0], s1[1]); w.y = pk2(s1[2], s1[3]); w.z = pk2(s1[4], s1[5]); w.w = pk2(s1[6], s1[7]); pf[2] = __builtin_bit_cast(bf16x8, w);
              w.x = pk2(s1[8], s1[9]); w.y = pk2(s1[10], s1[11]); w.z = pk2(s1[12], s1[13]); w.w = pk2(s1[14], s1[15]); pf[3] = __builtin_bit_cast(bf16x8, w); }
            { const LAS unsigned char* vb = ldsV + buf * VBUF + r32 * VSTR + hi * 16;
#pragma unroll
              for (int c = 0; c < 4; ++c)
#pragma unroll
                  for (int d = 0; d < NDVB; ++d) { const bf16x8 vf = *(const LAS bf16x8*)(vb + d * 32 * VSTR + c * 32); o[d] = __builtin_amdgcn_mfma_f32_32x32x16_bf16(vf, pf[c], o[d], 0, 0, 0); } }
            if (PIPE || t + 2 >= NT) ATT_WAITBAR(0); else ATT_WAITBAR(NDMA);
            if (PIPE) { s0 = n0; s1 = n1; }
            buf = buf1; buf1 = buf2; buf2 = buf2 == 2 ? 0 : buf2 + 1;
        }
#undef ATT_QK
#undef ATT_DMA
#undef ATT_WAITBAR
        const float inv = 1.0f / half_sum(l_run);
        gb op = O + (size_t)(qrow0 + wid * 32 + r32) * ldo + head * DV + 8 * hi;
#pragma unroll
        for (int d = 0; d < NDVB; ++d)
#pragma unroll
            for (int p = 0; p < 2; ++p) {
                const unsigned ax = pk2(o[d][8 * p] * inv, o[d][8 * p + 1] * inv), ay = pk2(o[d][8 * p + 2] * inv, o[d][8 * p + 3] * inv);
                const unsigned bx = pk2(o[d][8 * p + 4] * inv, o[d][8 * p + 5] * inv), by = pk2(o[d][8 * p + 6] * inv, o[d][8 * p + 7] * inv);
                const auto r1 = __builtin_amdgcn_permlane32_swap(ax, bx, false, false), r2 = __builtin_amdgcn_permlane32_swap(ay, by, false, false);
                u32x4 w; w.x = r1[0]; w.y = r2[0]; w.z = r1[1]; w.w = r2[1];
                *(GAS u32x4*)(op + 32 * d + 16 * p) = w; }
    }
}

#define XB_TMO      128
#define XB_XCNT(j)  (256  + 64 * (j))
#define XB_XSUB(j)  (1280 + 64 * (j))
#define XB_XGEN(j)  (2304 + 64 * (j))
#define XB_TOP      3328
#define XB_TOPGEN   3392
#define XCD_BAR_WORDS 3456
#define XB_SPIN_CAP (1u << 21)

__device__ __forceinline__ unsigned xb_ld(unsigned* p)              { return __hip_atomic_load(p, __ATOMIC_RELAXED, __HIP_MEMORY_SCOPE_AGENT); }
__device__ __forceinline__ unsigned xb_add(unsigned* p, unsigned v) { return __hip_atomic_fetch_add(p, v, __ATOMIC_RELAXED, __HIP_MEMORY_SCOPE_AGENT); }
__device__ __forceinline__ unsigned xb_xcc_id() { return (unsigned)__builtin_amdgcn_s_getreg((3 << 11) | 20) & 0xFu; }
#define XB_SPIN(cond, bar) do { unsigned _sp = 0; while (cond) { __builtin_amdgcn_s_sleep(1); \
    if ((++_sp & 255u) == 0u) { if (xb_ld(&(bar)[XB_TMO])) break; if (_sp > XB_SPIN_CAP) { atomicAdd(&(bar)[XB_TMO], 1u); break; } } } } while (0)

struct XcdBarrier {
    unsigned* bar; unsigned x;
    volatile LAS unsigned* st;
};

__device__ __forceinline__ XcdBarrier xcd_barrier_post(unsigned* bar, volatile LAS unsigned* st) {
    XcdBarrier b; b.bar = bar; b.x = xb_xcc_id(); b.st = st;
    if (threadIdx.x == 0) (void)xb_add(&bar[XB_XCNT(b.x)], 1u);
    return b;
}
__device__ __forceinline__ void xcd_barrier_complete(unsigned* bar, unsigned x, unsigned& nloc, unsigned& nx) {
    const unsigned G = gridDim.x * gridDim.y * gridDim.z;
    unsigned sum, cnt, mine, sp = 0u;
    for (;;) {
        sum = 0u; cnt = 0u; mine = 0u;
#pragma unroll
        for (unsigned j = 0; j < 16; ++j) { const unsigned c = xb_ld(&bar[XB_XCNT(j)]); sum += c; cnt += (c > 0u) ? 1u : 0u; mine = (j == x) ? c : mine; }
        if (sum == G) break;
        __builtin_amdgcn_s_sleep(1);
        if ((++sp & 255u) == 0u) { if (xb_ld(&bar[XB_TMO])) break; if (sp > XB_SPIN_CAP) { atomicAdd(&bar[XB_TMO], 1u); break; } }
    }
    nloc = mine > 0u ? mine : 1u; nx = cnt > 0u ? cnt : 1u;
}

__device__ __forceinline__ void xcd_barrier(const XcdBarrier& b) {
    asm volatile("s_waitcnt vmcnt(0)" ::: "memory");
    __syncthreads();
    if (threadIdx.x == 0) {
        unsigned* bar = b.bar;
        __builtin_amdgcn_s_waitcnt(0);
        unsigned nloc = b.st[0], nx = b.st[1];
        if (nloc == 0u) { xcd_barrier_complete(bar, b.x, nloc, nx); b.st[0] = nloc; b.st[1] = nx; }
        const unsigned old = xb_add(&bar[XB_XSUB(b.x)], 1u);
        const unsigned gen = old / nloc;
        if (old + 1u == (gen + 1u) * nloc) {
            __builtin_amdgcn_fence(__ATOMIC_RELEASE, "agent");
            asm volatile("s_waitcnt vmcnt(0)" ::: "memory");
            const unsigned og = xb_add(&bar[XB_TOP], 1u);
            const unsigned tg = og / nx;
            if (og + 1u == (tg + 1u) * nx) xb_add(&bar[XB_TOPGEN], 1u);
            else XB_SPIN(xb_ld(&bar[XB_TOPGEN]) == tg, bar);
            __builtin_amdgcn_fence(__ATOMIC_ACQUIRE, "agent");
            xb_add(&bar[XB_XGEN(b.x)], 1u);
            asm volatile("s_waitcnt vmcnt(0)" ::: "memory");
        } else {
            XB_SPIN(xb_ld(&bar[XB_XGEN(b.x)]) == gen, bar);
            __builtin_amdgcn_fence(__ATOMIC_ACQUIRE, "agent");
            asm volatile("s_waitcnt vmcnt(0)" ::: "memory");
        }
    }
    __syncthreads();
}

#define KARG(i) ((gcf)(*(const __attribute__((address_space(4))) unsigned long long*)(kp + 8 * (i))))
#define PHASE_BEGIN int tid_ = threadIdx.x; asm volatile("" : "+v"(tid_)); const int tid = tid_, lane = tid & 63, wid = __builtin_amdgcn_readfirstlane(tid >> 6); const __attribute__((address_space(4))) unsigned char* kp = (const __attribute__((address_space(4))) unsigned char*)__builtin_amdgcn_kernarg_segment_ptr(); asm volatile("" : "+s"(kp)); int G = gridDim.x, bx = __builtin_amdgcn_readfirstlane((int)MISC[5]); asm volatile("" : "+s"(G), "+s"(bx)); const int vcu = __builtin_amdgcn_readfirstlane((int)MISC[4]); Ptrs P; P.bx = bx; P.G = G; P.x = KARG(0); P.c = KARG(1); P.ctx = KARG(2); P.c_ctx = KARG(3); P.w_mod = KARG(4); P.b_mod = KARG(5); P.g_norm = KARG(6); P.w_ffn_in = KARG(7); P.w_ffn_out = KARG(8); P.a_w_in = KARG(9); P.a_g_q = KARG(10); P.a_g_kv = KARG(11); P.a_w_qb = KARG(12); P.a_w_kvb = KARG(13); P.a_w_o = KARG(14); P.b_w_qkv = KARG(15); P.b_lambda = KARG(16); P.b_g_sub = KARG(17); P.b_w_o = KARG(18); P.c_w_qkv = KARG(19); P.c_sink = KARG(20); P.c_w_o = KARG(21); P.g_final = KARG(22); P.out = (gf)KARG(23); P.ws = (GAS unsigned char*)KARG(24);
struct Args { const float* in[23]; float* out; unsigned char* ws; int ph_lo, ph_hi; };

__global__ void __launch_bounds__(512, 2) fwd_kernel(Args args) {
    extern __shared__ __attribute__((aligned(16))) unsigned char lds_raw[];
    LAS unsigned char* lds = (LAS unsigned char*)lds_raw;
    cg::grid_group grid = cg::this_grid();
    volatile LAS unsigned* MISC = (volatile LAS unsigned*)(lds + 143360 + 512);
    if (threadIdx.x < 8) MISC[threadIdx.x] = 0u;
    __syncthreads();
    if (threadIdx.x == 0) {
        const unsigned x = xb_xcc_id(); unsigned* bar0 = (unsigned*)(args.ws + WS_BAR);
        const unsigned rank = xb_add(&bar0[XB_XCNT(x)], 1u);
        const unsigned G0 = gridDim.x, bx0 = blockIdx.x;
        MISC[2] = rank; MISC[3] = x; MISC[4] = (G0 % 8 == 0) ? (bx0 % 8) * (G0 / 8) + bx0 / 8 : bx0; MISC[5] = bx0;
    }
    __syncthreads();

    for (int ph = args.ph_lo; ph < args.ph_hi; ++ph) {
        const unsigned pw = __builtin_amdgcn_readfirstlane(PROG_D.e[ph]);
        const int op = pw & 0xff, l = (pw >> 8) & 0xff, sraw = (pw >> 16) & 0xff, s = sraw & 3, rep = sraw >> 7;
#ifdef ONLY_OP
        if (op != ONLY_OP) continue;
#endif
        const int kind = l % 3;
#ifdef ONLY_KIND
        if (kind != ONLY_KIND) continue;
#endif
#define PHASE_LOCALS gcb Wl = (gcb)(P.ws + WS_W0 + (size_t)(l & 1) * WS_WSZ); gcb HN = (gcb)(P.ws + WS_HN); GAS unsigned char* Sb = P.ws + WS_S; gcf tab = (gcf)(P.ws + WS_TAB); gcf modl = (gcf)(P.ws + WS_MODS) + (size_t)l * 9 * NMODC; gf X = (gf)(P.ws + WS_X); \
        (void)Wl; (void)HN; (void)Sb; (void)tab; (void)modl; (void)X; (void)tid; (void)lane; (void)wid; (void)vcu;
        switch (op) {
        case OP_PRO: { PHASE_BEGIN PHASE_LOCALS prologue(P, lds, tid, wid, lane); } break;
        case OP_NORM: { PHASE_BEGIN PHASE_LOCALS
            norm_phase(P, l, s, wid, lane);
            if (s == 0 && l + 1 < 4) conv_layer(P, l + 1, lds, tid, wid, lane);
        } break;
        case OP_FFN_IN: { PHASE_BEGIN PHASE_LOCALS
            const int M = (l == 3 && s == 1) ? MLAT : MTOT;
            EpiSwiglu E{(gb)(Sb + S_HH)};
            run_gemm(lds, G, bx, HN, Wl + (s ? OFF_WIN1 : OFF_WIN0), M, 2 * DFF, DM, E);
        } break;
        case OP_FFN_OUT: case OP_MIX_OUT: { PHASE_BEGIN PHASE_LOCALS
            const bool ffn = (op == OP_FFN_OUT);
            const int M = (l == 3 && (!ffn || s == 1)) ? MLAT : MTOT;
            EpiResid E{(gcf)X, (gcf)(X + (size_t)MLAT * DM), X, modl + (size_t)(ffn ? (s ? 8 : 2) : 5) * DM, rep ? 0u : (ffn ? 0x3f000000u : 0x3f800000u)};
            gcb A = ffn ? (gcb)(Sb + S_HH) : HN;
            gcb Bt = ffn ? Wl + (s ? OFF_WOUT1 : OFF_WOUT0) : Wl + OFF_MIX + (kind == 0 ? MLA_WO : kind == 1 ? DIF_WO : SWA_WO);
            run_gemm(lds, G, bx, A, Bt, M, DM, ffn ? DFF : DM, E, ffn && (!rep || PROBE_SKIP_EPI));
        } break;
        case OP_MLA_IN: { PHASE_BEGIN PHASE_LOCALS
            EpiF32 E{(gf)(Sb + S_A), 768};
            run_gemm(lds, G, bx, HN, Wl + OFF_MIX + MLA_WA, MTOT, 768, DM, E);
        } break;
        case OP_MLA_ROW: { PHASE_BEGIN PHASE_LOCALS mla_row_phase(P, l, wid, lane); } break;
        case OP_PROJ: { PHASE_BEGIN PHASE_LOCALS
            if (kind == 0) {
                { EpiRope E{(gb)(Sb + S_Q), 1536, 192, 128, 1536, 0.07216878364870322f * LOG2E, tab};
                  run_gemm(lds, G, bx, (gcb)(Sb + S_CQN), Wl + OFF_MIX + MLA_WQB, MTOT, 1536, 384, E); }
                { EpiStoreBf16 E{(gb)(Sb + S_KN), 1024};
                  run_gemm(lds, G, bx, (gcb)(Sb + S_CKVN), Wl + OFF_MIX + MLA_WKN, MTOT, 1024, 256, E); }
                { EpiStoreBf16 E{(gb)(Sb + S_VT_MLA), MTOT};
                  run_gemm(lds, G, bx, Wl + OFF_MIX + MLA_WVT, (gcb)(Sb + S_CKVN), 1024, MTOT, 256, E); }
            } else {
                const int nqk = kind == 1 ? 2048 : 1280, nv = kind == 1 ? 1024 : 256;
                { EpiRope E{(gb)(Sb + S_QK), nqk, 64, 0, 1024, 0.125f * LOG2E, tab};
                  run_gemm(lds, G, bx, HN, Wl + OFF_MIX + (kind == 1 ? DIF_WQK : SWA_WQK), MTOT, nqk, DM, E); }
                { EpiStoreBf16 E{(gb)(Sb + (kind == 1 ? S_VT_DIFF : S_VT_SWA)), MTOT};
                  run_gemm(lds, G, bx, Wl + OFF_MIX + (kind == 1 ? DIF_WV : SWA_WV), HN, nv, MTOT, DM, E); }
            }
        } break;
        case OP_ATT: { PHASE_BEGIN PHASE_LOCALS
            if (kind == 0)
                attn_phase<192, 128, true, false, false>(lds, (gcb)(Sb + S_Q), 1536, (gcb)(Sb + S_KN), 1024, (gcb)(Sb + S_KR), (gcb)(Sb + S_VT_MLA), (gb)(P.ws + WS_HN), 1024, 8, 1, 1, P.c_sink, l < 3, vcu, G);
            else if (kind == 1)
                attn_phase<64, 128, false, false, false>(lds, (gcb)(Sb + S_QK), 2048, (gcb)(Sb + S_QK) + 1024, 2048, (gcb)(Sb + S_QK), (gcb)(Sb + S_VT_DIFF), (gb)(Sb + S_O2), 2048, 16, 1, 2, P.c_sink, true, vcu, G);
            else
                attn_phase<64, 64, false, true, true>(lds, (gcb)(Sb + S_QK), 1280, (gcb)(Sb + S_QK) + 1024, 1280, (gcb)(Sb + S_QK), (gcb)(Sb + S_VT_SWA), (gb)(P.ws + WS_HN), 1024, 16, 4, 4, P.c_sink, true, vcu, G);
        } break;
        case OP_DIFF_ROW: { PHASE_BEGIN PHASE_LOCALS diff_row_phase(P, wid, lane); } break;
        case OP_FINAL: { PHASE_BEGIN PHASE_LOCALS final_phase(P, wid, lane); } break;
        default: break;
        }
        __syncthreads();
        if (ph + 1 < args.ph_hi) {
            if (ph == 0) { grid.sync();
                if (threadIdx.x == 0) {
                    unsigned* bar0 = (unsigned*)(args.ws + WS_BAR); const unsigned x = MISC[3], rank = MISC[2], G0 = gridDim.x;
                    unsigned pre = 0u, idx = 0u, nx = 0u; bool uni = true;
                    for (unsigned j = 0; j < 16; ++j) { const unsigned cj = xb_ld(&bar0[XB_XCNT(j)]); if (j < x) { pre += cj; idx += cj ? 1u : 0u; } if (cj) { ++nx; if (cj * 8u != G0) uni = false; } }
                    if (nx == 8u && uni) { MISC[4] = pre + rank; MISC[5] = rank * 8u + idx; }
                }
                __syncthreads(); }
            else { XcdBarrier b; b.bar = (unsigned*)(args.ws + WS_BAR); b.x = xb_xcc_id(); b.st = MISC; xcd_barrier(b); if (DUP_SYNC) xcd_barrier(b); }
        }
    }
}

#ifndef N_LAUNCH_MODE
#define N_LAUNCH_MODE 1
#endif
extern "C" void kernel_launch(void* const* d_in, const int* in_sizes, int n_in, void* d_out, int out_size, void* d_ws, size_t ws_size, hipStream_t stream) {
    static int grid = 0;
    if (grid == 0) {
        if (n_in != 23 || out_size != MLAT * DM || ws_size < WS_END) { fprintf(stderr, "kernel_launch: unexpected problem (n_in %d out %d ws %zu need %zu)\n", n_in, out_size, ws_size, (size_t)WS_END); grid = -1; return; }
        int dev = 0, cus = 0, per_cu = 0;
        hipGetDevice(&dev); hipDeviceGetAttribute(&cus, hipDeviceAttributeMultiprocessorCount, dev);
        if (hipFuncSetAttribute((const void*)fwd_kernel, hipFuncAttributeMaxDynamicSharedMemorySize, LDS_BYTES) != hipSuccess) { fprintf(stderr, "kernel_launch: hipFuncSetAttribute failed\n"); grid = -1; return; }
        if (hipOccupancyMaxActiveBlocksPerMultiprocessor(&per_cu, (const void*)fwd_kernel, 512, LDS_BYTES) != hipSuccess || per_cu < 1) { fprintf(stderr, "kernel_launch: occupancy query gave %d\n", per_cu); per_cu = 1; }
        (void)hipGetLastError();
        grid = cus * 1;
    }
    if (grid < 0) return;
    if (hipMemsetAsync((char*)d_ws + WS_BAR, 0, BAR_ZERO_BYTES, stream) != hipSuccess) { fprintf(stderr, "kernel_launch: memset of barrier words failed\n"); return; }
    Args a{};
    for (int i = 0; i < 23; ++i) a.in[i] = (const float*)d_in[i];
    a.out = (float*)d_out; a.ws = (unsigned char*)d_ws;
#if N_LAUNCH_MODE == 1
    a.ph_lo = 0; a.ph_hi = NPHASE;
    { void* kargs[] = {&a}; hipError_t e = hipLaunchCooperativeKernel((const void*)fwd_kernel, dim3(grid), dim3(512), kargs, LDS_BYTES, stream);
      if (e != hipSuccess) fprintf(stderr, "cooperative launch failed: %s (grid %d)\n", hipGetErrorString(e), grid); }
#else
    for (int ph = 0; ph < NPHASE; ++ph) { a.ph_lo = ph; a.ph_hi = ph + 1; void* kargs[] = {&a};
        hipError_t e = hipLaunchCooperativeKernel((const void*)fwd_kernel, dim3(grid), dim3(512), kargs, LDS_BYTES, stream);
        if (e != hipSuccess) { fprintf(stderr, "launch %d failed: %s\n", ph, hipGetErrorString(e)); break; } }
#endif
}
```

```cpp
#include <hip/hip_runtime.h>
#include <hip/hip_cooperative_groups.h>
#include <cstdio>
#include <cstdint>
namespace cg = cooperative_groups;
__device__ __forceinline__ float opaque_zero() { float z; asm volatile("v_mov_b32 %0, 0" : "=v"(z)); return z; }
namespace pg8 {
#define PG8_LAS __attribute__((address_space(3)))
typedef unsigned short bf16_t;
typedef short bf16x8 __attribute__((ext_vector_type(8)));
typedef float f32x4 __attribute__((ext_vector_type(4)));
typedef unsigned u32x4 __attribute__((ext_vector_type(4)));
constexpr int BM = 256, BK = 64, HALF = 128, HTB = HALF * BK * 2  , STAGE_BYTES = 8 * HTB, NXCD = 8, WGM = 8;

__host__ __device__ __forceinline__ int lds_byte(int r, int c) { const int st = (r >> 4) * 2 + (c >> 5), rr = r & 15, cc = c & 31, ob = rr * 64 + cc * 2; return st * 1024 + (ob ^ (((ob >> 9) & 1) << 5)); }
__host__ __device__ __forceinline__ void stage_rc(int b, int& R, int& C) { const int st = b / 1024, sb = b % 1024, swz = sb ^ (((sb >> 9) & 1) << 5); R = (st >> 1) * 16 + swz / 64; C = (st & 1) * 32 + (swz % 64) / 2; }
__host__ __device__ __forceinline__ int perm32(int rho) { const int n = rho >> 4, i = rho & 15; return 8 * (i >> 2) + 4 * n + (i & 3); }

struct Unit { int pm, pn, k0, nt, split; };
struct Gemm { const bf16_t* A; const bf16_t* Bt; int M, N, K; };

struct StaticOrder {
    int nM, nN, nwg, G, c, ntk, nfull, L, P;
    __host__ __device__ void init(int M, int N, int G_, int c_, int ntk_, bool split) {
        nM = M / BM; nN = N / BM; G = G_; c = c_; ntk = ntk_; L = 0; P = 1;
        if (split && nM == 136 && (128 * nN) % G == 0 && G % (8 * nN) == 0 && G / (8 * nN) <= ntk / 2) { nM = 128; L = 8 * nN; P = G / L; }
        nwg = nM * nN; nfull = nwg;
    }
    __host__ __device__ void map(int wgid, Unit& u) const {
        { const int q = nwg / NXCD, r = nwg % NXCD, xcd = wgid % NXCD, off = wgid / NXCD; wgid = (xcd < r ? xcd * (q + 1) : r * (q + 1) + (xcd - r) * q) + off; }
        const int nig = WGM * nN, gid = wgid / nig, fm = gid * WGM, gsz = (nM - fm) < WGM ? (nM - fm) : WGM;
        u.pm = fm + ((wgid % nig) % gsz); u.pn = (wgid % nig) / gsz;
    }
    __host__ __device__ bool next(int i, Unit& u) const {
        if (L > 0 && (c & 1)) { if (i == 0) { if (c >= L * P) return false; goto piece; } --i; if ((long)i * G + c >= nfull) return false; }
        { const long Lid = (long)i * G + c;
          if (Lid < nfull) { map((int)Lid, u); u.k0 = 0; u.nt = ntk; u.split = 0; return true; } }
        if (L == 0 || i != nfull / G || c >= L * P) return false;
        piece:
        const int j = c / P, piece = c % P, pairs = ntk / 2, base = pairs / P, rem = pairs % P;
        u.pm = 128 + j / nN; u.pn = j % nN;
        u.k0 = 2 * (piece * base + (piece < rem ? piece : rem)); u.nt = 2 * (base + (piece < rem ? 1 : 0)); u.split = piece + 1; return true;
    }
    __device__ __forceinline__ void a_ready(const Unit&) const {}
    __device__ __forceinline__ void done(const Unit&) const {}
};

template <class Epi, class Sched, bool ALIGN_EPI = false, bool SP2 = false>
__device__ __forceinline__ void gemm_phase(PG8_LAS unsigned char* lds, const Gemm g, const Sched& S, const Epi& E) {
    int tid_ = threadIdx.x; asm volatile("" : "+v"(tid_));
    const int tid = tid_, wid = __builtin_amdgcn_readfirstlane(tid >> 6), lane = tid & 63, wr = wid >> 2, wc = wid & 3, fr = lane & 15, fq = lane >> 4;
    const int K = g.K, nt = K / BK;
    unsigned voffA[2], voffB[2];
#pragma unroll
    for (int i = 0; i < 2; ++i) { int R, C; stage_rc(tid * 16 + i * 8192, R, C); const int Rb = Epi::PERM ? ((R & ~31) + perm32(R & 31)) : R;
        voffA[i] = (unsigned)(R * K + C) * 2u; voffB[i] = (unsigned)(Rb * K + C) * 2u; }
    const size_t kstep = (size_t)(BK * 2);
    const size_t hstep = (size_t)HALF * K * 2;
    const size_t tstep = 2 * hstep;
    const unsigned ldsw = (unsigned)wid * 1024u;
    const int aoff = lds_byte(wr * 64 + fr, fq * 8), boff = lds_byte(wc * 32 + fr, fq * 8);
#define PG8_SA(b, h) (((b) * 2 + (h)) * HTB)
#define PG8_SB(b, h) ((4 + (b) * 2 + (h)) * HTB)
#define PG8_STAGE(bufoff, gbase, voff) do { _Pragma("unroll") for (int _i = 0; _i < 2; ++_i) \
        __builtin_amdgcn_global_load_lds((const unsigned*)((const char*)(gbase) + (voff)[_i]), (PG8_LAS unsigned*)(lds + (bufoff) + ldsw + _i * 8192), 16, 0, 0); } while (0)
#define PG8_LDA(dst, b, h) do { _Pragma("unroll") for (int m = 0; m < 4; ++m) _Pragma("unroll") for (int k = 0; k < 2; ++k) dst[m][k] = *(const PG8_LAS bf16x8*)(lds + PG8_SA(b, h) + aoff + m * 2048 + k * 1024); } while (0)
#define PG8_LDB(dst, b, h) do { _Pragma("unroll") for (int n = 0; n < 2; ++n) _Pragma("unroll") for (int k = 0; k < 2; ++k) dst[n][k] = *(const PG8_LAS bf16x8*)(lds + PG8_SB(b, h) + boff + n * 2048 + k * 1024); } while (0)
#define PG8_MMA(ai, bj, At, Bt) do { __builtin_amdgcn_s_setprio(1); _Pragma("unroll") for (int m = 0; m < 4; ++m) _Pragma("unroll") for (int n = 0; n < 2; ++n) _Pragma("unroll") for (int k = 0; k < 2; ++k) \
        acc[ai][bj][m][n] = __builtin_amdgcn_mfma_f32_16x16x32_bf16(Bt[n][k], At[m][k], acc[ai][bj][m][n], 0, 0, 0); __builtin_amdgcn_s_setprio(0); } while (0)
#define PG8_WAIT_V(n) asm volatile("s_waitcnt vmcnt(" #n ")" ::: "memory")
#define PG8_WAIT_L(n) asm volatile("s_waitcnt lgkmcnt(" #n ")" ::: "memory")
#define PG8_BAR __builtin_amdgcn_s_barrier()
#define PG8_SCHED __builtin_amdgcn_sched_barrier(0)
    Unit cur, nxt; int ui = 0;
    if (!S.next(0, cur)) return;
    f32x4 acc[2][2][4][2];
#pragma unroll
    for (int a = 0; a < 2; ++a)
#pragma unroll
        for (int b = 0; b < 2; ++b)
#pragma unroll
            for (int m = 0; m < 4; ++m)
#pragma unroll
                for (int n = 0; n < 2; ++n) { const float z0_ = opaque_zero(); acc[a][b][m][n] = (f32x4){z0_, z0_, z0_, z0_}; }
    bf16x8 At[4][2], B0[2][2], B1[2][2];
    const char* cA = (const char*)g.A + (size_t)cur.pm * tstep + (size_t)cur.k0 * kstep; const char* cB = (const char*)g.Bt + (size_t)cur.pn * tstep + (size_t)cur.k0 * kstep;
    S.a_ready(cur);
    if constexpr (SP2) {
        PG8_STAGE(PG8_SB(0, 0), cB, voffB); PG8_STAGE(PG8_SB(0, 1), cB + hstep, voffB); PG8_STAGE(PG8_SA(0, 0), cA, voffA); PG8_STAGE(PG8_SA(0, 1), cA + hstep, voffA);
        if (wr == 1) PG8_BAR;
        PG8_WAIT_V(2); PG8_BAR;
        PG8_STAGE(PG8_SB(1, 0), cB + kstep, voffB); PG8_STAGE(PG8_SA(1, 0), cA + kstep, voffA); PG8_STAGE(PG8_SB(1, 1), cB + hstep + kstep, voffB);
        PG8_WAIT_V(6); PG8_BAR;
    } else {
        PG8_STAGE(PG8_SB(0, 0), cB, voffB); PG8_STAGE(PG8_SA(0, 0), cA, voffA); PG8_STAGE(PG8_SB(0, 1), cB + hstep, voffB); PG8_STAGE(PG8_SA(0, 1), cA + hstep, voffA);
        if (wr == 1) PG8_BAR;
        PG8_WAIT_V(4); PG8_BAR;
        PG8_STAGE(PG8_SB(1, 0), cB + kstep, voffB); PG8_STAGE(PG8_SA(1, 0), cA + kstep, voffA); PG8_STAGE(PG8_SB(1, 1), cB + hstep + kstep, voffB);
        PG8_WAIT_V(6); PG8_BAR;
    }
    for (;;) {
        const bool has_next = S.next(ui + 1, nxt);
        const char* nA = has_next ? (const char*)g.A + (size_t)nxt.pm * tstep + (size_t)nxt.k0 * kstep : cA; const char* nB = has_next ? (const char*)g.Bt + (size_t)nxt.pn * tstep + (size_t)nxt.k0 * kstep : cB;
        const int nt_u = cur.nt;
        for (int t = 0; t < nt_u; t += 2) {
            const bool last = (t == nt_u - 2);
            const char* a1 = cA + (size_t)(t + 1) * kstep;
            const char* a2 = last ? nA : cA + (size_t)(t + 2) * kstep; const char* b2 = last ? nB : cB + (size_t)(t + 2) * kstep;
            const char* a3 = a2 + kstep; const char* b3 = b2 + kstep;
            if (last && has_next) S.a_ready(nxt);
            if constexpr (SP2) {
            PG8_LDB(B0, 0, 0); PG8_LDB(B1, 0, 1); PG8_SCHED; PG8_LDA(At, 0, 0); PG8_STAGE(PG8_SA(1, 1), a1 + hstep, voffA);
            PG8_WAIT_V(8); PG8_WAIT_L(0); PG8_BAR; PG8_MMA(0, 0, At, B0); PG8_MMA(0, 1, At, B1); PG8_BAR; PG8_SCHED;
            PG8_LDA(At, 0, 1); PG8_STAGE(PG8_SB(0, 0), b2, voffB); PG8_STAGE(PG8_SB(0, 1), b2 + hstep, voffB); PG8_STAGE(PG8_SA(0, 0), a2, voffA);
            PG8_WAIT_V(8); PG8_WAIT_L(0); PG8_BAR; PG8_MMA(1, 0, At, B0); PG8_MMA(1, 1, At, B1); PG8_BAR; PG8_SCHED;
            PG8_LDB(B0, 1, 0); PG8_LDB(B1, 1, 1); PG8_SCHED; PG8_LDA(At, 1, 0); PG8_STAGE(PG8_SA(0, 1), a2 + hstep, voffA);
            PG8_WAIT_V(8); PG8_WAIT_L(0); PG8_BAR; PG8_MMA(0, 0, At, B0); PG8_MMA(0, 1, At, B1); PG8_BAR; PG8_SCHED;
            PG8_LDA(At, 1, 1); PG8_STAGE(PG8_SB(1, 0), b3, voffB); PG8_STAGE(PG8_SB(1, 1), b3 + hstep, voffB); PG8_STAGE(PG8_SA(1, 0), a3, voffA);
            PG8_WAIT_V(8); PG8_WAIT_L(0); PG8_BAR; PG8_MMA(1, 0, At, B0); PG8_MMA(1, 1, At, B1); PG8_BAR; PG8_SCHED;
            } else {
            PG8_LDB(B0, 0, 0); PG8_SCHED; PG8_LDA(At, 0, 0); PG8_STAGE(PG8_SA(1, 1), a1 + hstep, voffA);
            PG8_WAIT_L(8); PG8_BAR; PG8_WAIT_L(0); PG8_MMA(0, 0, At, B0); PG8_BAR; PG8_SCHED;
            PG8_LDB(B1, 0, 1); PG8_STAGE(PG8_SB(0, 0), b2, voffB);
            PG8_BAR; PG8_WAIT_L(0); PG8_MMA(0, 1, At, B1); PG8_BAR;
            PG8_LDA(At, 0, 1); PG8_STAGE(PG8_SA(0, 0), a2, voffA);
            PG8_BAR; PG8_WAIT_L(0); PG8_MMA(1, 0, At, B0); PG8_BAR; PG8_SCHED;
            PG8_STAGE(PG8_SB(0, 1), b2 + hstep, voffB);
            PG8_WAIT_V(6); PG8_BAR; PG8_MMA(1, 1, At, B1); PG8_BAR;
            PG8_LDB(B0, 1, 0); PG8_SCHED; PG8_LDA(At, 1, 0); PG8_STAGE(PG8_SA(0, 1), a2 + hstep, voffA);
            PG8_WAIT_L(8); PG8_BAR; PG8_WAIT_L(0); PG8_MMA(0, 0, At, B0); PG8_BAR; PG8_SCHED;
            PG8_LDB(B1, 1, 1); PG8_STAGE(PG8_SB(1, 0), b3, voffB);
            PG8_BAR; PG8_WAIT_L(0); PG8_MMA(0, 1, At, B1); PG8_BAR;
            PG8_LDA(At, 1, 1); PG8_STAGE(PG8_SA(1, 0), a3, voffA);
            PG8_BAR; PG8_WAIT_L(0); PG8_MMA(1, 0, At, B0); PG8_BAR; PG8_SCHED;
            PG8_STAGE(PG8_SB(1, 1), b3 + hstep, voffB);
            PG8_WAIT_V(6); PG8_BAR; PG8_MMA(1, 1, At, B1); PG8_BAR;
            }
        }
        if constexpr (ALIGN_EPI) { if (wr == 0) PG8_BAR; }
        if constexpr (!Epi::AFTER_DRAIN) { E(acc, cur, wr, wc, fr, fq); S.done(cur); }
        if (!has_next) break;
#pragma unroll
        for (int a = 0; a < 2; ++a)
#pragma unroll
            for (int b = 0; b < 2; ++b)
#pragma unroll
                for (int m = 0; m < 4; ++m)
#pragma unroll
                    for (int n = 0; n < 2; ++n) { const float z0_ = opaque_zero(); acc[a][b][m][n] = (f32x4){z0_, z0_, z0_, z0_}; }
        cur = nxt; cA = nA; cB = nB; ++ui;
        if constexpr (ALIGN_EPI) { if (wr == 1) PG8_BAR; }
    }
    PG8_WAIT_V(0);
    if constexpr (!ALIGN_EPI) { if (wr == 0) PG8_BAR; }
    PG8_BAR;
    if constexpr (Epi::AFTER_DRAIN) { E.fused(acc, cur, wr, wc, fr, fq, lds, wid, lane); S.done(cur); }
#undef PG8_SA
#undef PG8_SB
#undef PG8_STAGE
#undef PG8_LDA
#undef PG8_LDB
#undef PG8_MMA
#undef PG8_WAIT_V
#undef PG8_WAIT_L
#undef PG8_BAR
#undef PG8_SCHED
}
}

#define LAS __attribute__((address_space(3)))
#define GAS __attribute__((address_space(1)))
typedef unsigned short bf16_t;
typedef short bf16x8 __attribute__((ext_vector_type(8)));
typedef float f32x4 __attribute__((ext_vector_type(4)));
typedef float f32x2 __attribute__((ext_vector_type(2)));
typedef float f32x16 __attribute__((ext_vector_type(16)));
typedef unsigned u32x4 __attribute__((ext_vector_type(4)));
typedef unsigned u32x2 __attribute__((ext_vector_type(2)));
typedef const GAS float* gcf;
typedef GAS float* gf;
typedef const GAS bf16_t* gcb;
typedef GAS bf16_t* gb;

constexpr int DM = 1024, SEQ = 4096, NB = 8, CTXL = 256, DFF = 2816;
constexpr int MLAT = NB * SEQ;
constexpr int MTOT = MLAT + NB * CTXL;
constexpr int NMODC = 9 * DM;
constexpr float EPS = 1e-6f;
constexpr float LOG2E = 1.4426950408889634f;
constexpr float LAM_INIT = 0.35550906759096934f;

constexpr size_t MiB = 1u << 20;
constexpr size_t WS_MODS = 0, WS_TAB = 2 * MiB, WS_BAR = 3 * MiB, BAR_ZERO_BYTES = 16384, WS_W0 = 4 * MiB, WS_WSZ = 44 * MiB, WS_X = 92 * MiB, WS_HN = 228 * MiB, WS_S = 296 * MiB, WS_END = 636 * MiB;
constexpr size_t S_HH = 0, S_PART = 192 * MiB;
constexpr size_t S_A = 0, S_CQN = 102 * MiB, S_CKVN = 128 * MiB, S_KR = 146 * MiB, S_Q = 152 * MiB, S_KN = 0, S_VT_MLA = 256 * MiB;
constexpr size_t S_QK = 0, S_VT_DIFF = 136 * MiB, S_O2 = 204 * MiB, S_VT_SWA = 88 * MiB;
constexpr size_t OFF_WIN0 = 0, OFF_WOUT0 = 5767168, OFF_WIN1 = 8650752, OFF_WOUT1 = 14417920, OFF_MIX = 17301504;
constexpr size_t MLA_WA = 0, MLA_WQB = 786432, MLA_WKN = 1376256, MLA_WVT = 1638400, MLA_WO = 1900544;
constexpr size_t DIF_WQK = 0, DIF_WV = 2097152, DIF_WO = 3145728;
constexpr size_t SWA_WQK = 0, SWA_WV = 1310720, SWA_WO = 1572864;

constexpr int LDS_BYTES = 147456;

__device__ const float INVF[16] = {1.0f, 0.5623413324356079f, 0.3162277638912201f, 0.17782793939113617f, 0.10000000149011612f, 0.05623413249850273f, 0.03162277489900589f, 0.017782794311642647f,
                                   0.009999999776482582f, 0.005623413249850273f, 0.003162277629598975f, 0.0017782794311642647f, 0.0010000000474974513f, 0.000562341301701963f, 0.0003162277571391314f, 0.00017782794020604342f};

enum { OP_PRO = 0, OP_NORM, OP_FFN_IN, OP_FFN_OUT, OP_MLA_IN, OP_MLA_ROW, OP_PROJ, OP_ATT, OP_DIFF_ROW, OP_MIX_OUT, OP_FINAL };
#ifndef DUP_MASK
#define DUP_MASK 0
#endif
#ifndef DUP_SYNC
#define DUP_SYNC 0
#endif
#ifndef PROBE_SKIP_EPI
#define PROBE_SKIP_EPI 0
#endif
struct Prog { unsigned e[128]; int n; };
constexpr void prog_add(Prog& p, int op, int l, int s) {
    p.e[p.n++] = (unsigned)op | ((unsigned)l << 8) | ((unsigned)s << 16);
    if ((DUP_MASK >> op) & 1) p.e[p.n++] = (unsigned)op | ((unsigned)l << 8) | ((unsigned)(s | 0x80) << 16);
}
constexpr Prog make_prog() {
    Prog p{}; p.n = 0;
    prog_add(p, OP_PRO, 0, 0);
    for (int l = 0; l < 4; ++l) {
        const int kind = l % 3;
        prog_add(p, OP_NORM, l, 0); prog_add(p, OP_FFN_IN, l, 0); prog_add(p, OP_FFN_OUT, l, 0); prog_add(p, OP_NORM, l, 1);
        if (kind == 0) { prog_add(p, OP_MLA_IN, l, 0); prog_add(p, OP_MLA_ROW, l, 0); }
        prog_add(p, OP_PROJ, l, 0); prog_add(p, OP_ATT, l, 0);
        if (kind == 1) prog_add(p, OP_DIFF_ROW, l, 0);
        prog_add(p, OP_MIX_OUT, l, 0); prog_add(p, OP_NORM, l, 2); prog_add(p, OP_FFN_IN, l, 1); prog_add(p, OP_FFN_OUT, l, 1);
    }
    prog_add(p, OP_FINAL, 0, 0);
    return p;
}
constexpr Prog PROG_H = make_prog();
constexpr int NPHASE = PROG_H.n;
__device__ const Prog PROG_D = make_prog();

__device__ __forceinline__ unsigned pk2(float lo, float hi) { typedef __bf16 bf16x2_t __attribute__((ext_vector_type(2))); f32x2 v = {lo, hi}; bf16x2_t b = __builtin_convertvector(v, bf16x2_t); return __builtin_bit_cast(unsigned, b); }
__device__ __forceinline__ float wave_sum_l(float v, int lane) {
#pragma unroll
    for (int o = 1; o < 64; o <<= 1) v += __int_as_float(__builtin_amdgcn_ds_bpermute((lane ^ o) << 2, __float_as_int(v)));
    return v;
}
#define wave_sum(v) wave_sum_l((v), lane)
__device__ __forceinline__ float fast_exp2(float x) { return __builtin_amdgcn_exp2f(x); }
__device__ __forceinline__ float silu_fast(float x) { return x * __builtin_amdgcn_rcpf(1.0f + __builtin_amdgcn_exp2f(-x * LOG2E)); }
__device__ __forceinline__ float half_max(float m) { auto rr = __builtin_amdgcn_permlane32_swap(__float_as_uint(m), __float_as_uint(m), false, false); return fmaxf(__uint_as_float(rr[0]), __uint_as_float(rr[1])); }
__device__ __forceinline__ float half_sum(float m) { auto rr = __builtin_amdgcn_permlane32_swap(__float_as_uint(m), __float_as_uint(m), false, false); return __uint_as_float(rr[0]) + __uint_as_float(rr[1]); }

struct EpiStoreBf16 {
    static constexpr bool PERM = true, AFTER_DRAIN = false;
    gb O; int ldc;
    __device__ __forceinline__ void operator()(const f32x4 (&acc)[2][2][4][2], const pg8::Unit& u, int wr, int wc, int fr, int fq) const {
        const int row0 = u.pm * 256 + wr * 64 + fr, col0 = u.pn * 256 + wc * 32 + 8 * fq;
#pragma unroll
        for (int ai = 0; ai < 2; ++ai)
#pragma unroll
            for (int m = 0; m < 4; ++m) { gb rowp = O + (size_t)(row0 + ai * 128 + m * 16) * ldc + col0;
#pragma unroll
                for (int bj = 0; bj < 2; ++bj) { const f32x4 v0 = acc[ai][bj][m][0], v1 = acc[ai][bj][m][1];
                    u32x4 w; w.x = pk2(v0[0], v0[1]); w.y = pk2(v0[2], v0[3]); w.z = pk2(v1[0], v1[1]); w.w = pk2(v1[2], v1[3]);
                    *(GAS u32x4*)(rowp + bj * 128) = w; } }
    }
};
struct EpiSwiglu {
    static constexpr bool PERM = true, AFTER_DRAIN = false;
    gb O;
    __device__ __forceinline__ void operator()(const f32x4 (&acc)[2][2][4][2], const pg8::Unit& u, int wr, int wc, int fr, int fq) const {
        const int row0 = u.pm * 256 + wr * 64 + fr, col0 = u.pn * 128 + wc * 32 + 8 * fq;
#pragma unroll
        for (int ai = 0; ai < 2; ++ai)
#pragma unroll
            for (int m = 0; m < 4; ++m) { gb rowp = O + (size_t)(row0 + ai * 128 + m * 16) * DFF + col0;
                const f32x4 g0 = acc[ai][0][m][0], g1 = acc[ai][0][m][1], u0 = acc[ai][1][m][0], u1 = acc[ai][1][m][1];
                u32x4 w; w.x = pk2(silu_fast(g0[0]) * u0[0], silu_fast(g0[1]) * u0[1]); w.y = pk2(silu_fast(g0[2]) * u0[2], silu_fast(g0[3]) * u0[3]);
                w.z = pk2(silu_fast(g1[0]) * u1[0], silu_fast(g1[1]) * u1[1]); w.w = pk2(silu_fast(g1[2]) * u1[2], silu_fast(g1[3]) * u1[3]);
                *(GAS u32x4*)rowp = w; }
    }
};
struct EpiResid {
    static constexpr bool PERM = true, AFTER_DRAIN = false;
    gcf base_lat, base_ctx; gf X; gcf gate; unsigned gsc_bits;
    __device__ __forceinline__ void operator()(const f32x4 (&acc)[2][2][4][2], const pg8::Unit& u, int wr, int wc, int fr, int fq) const {
        if (PROBE_SKIP_EPI && gsc_bits == 0u) return;
        const int b = u.pm < 128 ? (u.pm >> 4) : 8;
        const int col0 = u.pn * 256 + wc * 32 + 8 * fq;
        gcf gp = gate + (size_t)b * NMODC + col0;
        f32x4 gv[2][2];
#pragma unroll
        for (int bj = 0; bj < 2; ++bj)
#pragma unroll
            for (int n = 0; n < 2; ++n) gv[bj][n] = *(const GAS f32x4*)(gp + bj * 128 + n * 4) * __uint_as_float(gsc_bits);
#pragma unroll
        for (int ai = 0; ai < 2; ++ai)
#pragma unroll
            for (int m = 0; m < 4; ++m) { const int row = u.pm * 256 + ai * 128 + wr * 64 + m * 16 + fr;
                gcf bp = (row < MLAT ? base_lat + (size_t)row * DM : base_ctx + (size_t)(row - MLAT) * DM) + col0;
                gf xp = X + (size_t)row * DM + col0;
#pragma unroll
                for (int bj = 0; bj < 2; ++bj)
#pragma unroll
                    for (int n = 0; n < 2; ++n) {
                        if (u.split) { gf part = (gf)((GAS unsigned char*)X + (WS_S + S_PART - WS_X)); *(GAS f32x4*)(part + ((size_t)(u.split - 1) * 2048 + (row - MLAT)) * DM + col0 + bj * 128 + n * 4) = acc[ai][bj][m][n]; }
                        else { const f32x4 bs = *(const GAS f32x4*)(bp + bj * 128 + n * 4); *(GAS f32x4*)(xp + bj * 128 + n * 4) = bs + gv[bj][n] * acc[ai][bj][m][n]; } } }
    }
};
struct EpiF32 {
    static constexpr bool PERM = false, AFTER_DRAIN = false;
    gf O; int ldc;
    __device__ __forceinline__ void operator()(const f32x4 (&acc)[2][2][4][2], const pg8::Unit& u, int wr, int wc, int fr, int fq) const {
        const int col0 = u.pn * 256 + wc * 32 + 4 * fq;
#pragma unroll
        for (int ai = 0; ai < 2; ++ai)
#pragma unroll
            for (int m = 0; m < 4; ++m) { gf op = O + (size_t)(u.pm * 256 + ai * 128 + wr * 64 + m * 16 + fr) * ldc + col0;
#pragma unroll
                for (int bj = 0; bj < 2; ++bj)
#pragma unroll
                    for (int n = 0; n < 2; ++n) *(GAS f32x4*)(op + bj * 128 + n * 16) = acc[ai][bj][m][n]; }
    }
};
struct EpiRope {
    static constexpr bool PERM = false, AFTER_DRAIN = false;
    gb O; int ldc, period, rope_start, nq; float qscale; gcf tab;
    __device__ __forceinline__ void operator()(const f32x4 (&acc)[2][2][4][2], const pg8::Unit& u, int wr, int wc, int fr, int fq) const {
        const bool lat = u.pm < 128;
#pragma unroll
        for (int bj = 0; bj < 2; ++bj) {
            const int colg = u.pn * 256 + bj * 128 + wc * 32, cm = colg % period;
            const bool rope = lat && (cm >= rope_start);
            const int axis = ((cm - rope_start) >> 5) & 1;
            const float sc = colg < nq ? qscale : 1.0f;
#pragma unroll
            for (int ai = 0; ai < 2; ++ai)
#pragma unroll
                for (int m = 0; m < 4; ++m) { const int row = u.pm * 256 + ai * 128 + wr * 64 + m * 16 + fr;
                    f32x4 x1 = acc[ai][bj][m][0], x2 = acc[ai][bj][m][1];
                    if (rope) { const int t = row & (SEQ - 1), pos = axis ? (t & 63) : (t >> 6);
                        const GAS f32x4* tp = (const GAS f32x4*)(tab + (pos * 16 + 4 * fq) * 2);
                        const f32x4 t0 = tp[0], t1 = tp[1];
                        const f32x4 c = {t0[0], t0[2], t1[0], t1[2]}, s = {t0[1], t0[3], t1[1], t1[3]};
                        const f32x4 o1 = x1 * c - x2 * s, o2 = x2 * c + x1 * s; x1 = o1; x2 = o2; }
                    x1 = x1 * sc; x2 = x2 * sc;
                    gb op = O + (size_t)row * ldc + colg + 4 * fq;
                    u32x2 w1, w2; w1.x = pk2(x1[0], x1[1]); w1.y = pk2(x1[2], x1[3]); w2.x = pk2(x2[0], x2[1]); w2.y = pk2(x2[2], x2[3]);
                    *(GAS u32x2*)op = w1; *(GAS u32x2*)(op + 16) = w2;
                    asm volatile("" ::: "memory"); }
        }
    }
};

template <class Epi> __device__ __forceinline__ void run_gemm(LAS unsigned char* lds, int G_, int bx_, gcb A, gcb Bt, int M, int N, int K, const Epi& E, bool split = false) {
    pg8::Gemm g{(const bf16_t*)A, (const bf16_t*)Bt, M, N, K}; pg8::StaticOrder S; S.init(M, N, G_, bx_, K / 64, split);
    pg8::gemm_phase<Epi, pg8::StaticOrder, true, true>(lds, g, S, E);
}

__device__ __forceinline__ unsigned f2bf(float f) { unsigned u = __builtin_bit_cast(unsigned, f); return (u + 0x7fffu + ((u >> 16) & 1u)) >> 16; }
__device__ __forceinline__ unsigned pk2s(float lo, float hi) { return f2bf(lo) | (f2bf(hi) << 16); }
__device__ __forceinline__ void conv_item(gcf W, int K, int N, int k0, int n0, gb drow, LAS float* scr, int lane) {
#pragma unroll 8
    for (int i = 0; i < 32; ++i) { const int kk = 2 * i + (lane >> 5); scr[kk * 33 + (lane & 31)] = W[(size_t)(k0 + kk) * N + n0 + (lane & 31)]; }
    asm volatile("s_waitcnt lgkmcnt(0)" ::: "memory");
    const int c = lane & 7;
#pragma unroll
    for (int j = 0; j < 4; ++j) { const int n = (lane >> 3) + 8 * j; const LAS float* s = scr + (8 * c) * 33 + n;
        u32x4 o; o.x = pk2s(s[0 * 33], s[1 * 33]); o.y = pk2s(s[2 * 33], s[3 * 33]); o.z = pk2s(s[4 * 33], s[5 * 33]); o.w = pk2s(s[6 * 33], s[7 * 33]);
        *(GAS u32x4*)(drow + (size_t)n * K + k0 + 8 * c) = o; }
    asm volatile("s_waitcnt lgkmcnt(0)" ::: "memory");
}
__device__ __forceinline__ bool conv_job(int& r, gcf W, int K, int N, int kind, gb d1, gb d2, int S, LAS float* scr, int lane) {
    const int nblk = N / 32, items = (K / 64) * nblk;
    if (r >= items) { r -= items; return false; }
    const int kb = r / nblk, nb = r % nblk, k0 = 64 * kb, n0 = 32 * nb;
    gb drow;
    if (kind == 0) drow = d1 + (size_t)n0 * K;
    else if (kind == 1) { const int nn = n0 < DFF ? n0 : n0 - DFF; drow = d1 + (size_t)(256 * (nn / 128) + (n0 < DFF ? 0 : 128) + (nn % 128)) * K; }
    else if (kind == 2) drow = n0 < S ? d1 + (size_t)n0 * K : d2 + (size_t)(n0 - S) * K;
    else { const int h = n0 / 256, off = n0 % 256; drow = off < 128 ? d1 + (size_t)(h * 128 + off) * K : d2 + (size_t)(h * 128 + off - 128) * K; }
    conv_item(W, K, N, k0, n0, drow, scr, lane);
    return true;
}

struct Ptrs {
    gcf x, c, ctx, c_ctx, w_mod, b_mod, g_norm, w_ffn_in, w_ffn_out, a_w_in, a_g_q, a_g_kv, a_w_qb, a_w_kvb, a_w_o, b_w_qkv, b_lambda, b_g_sub, b_w_o, c_w_qkv, c_sink, c_w_o, g_final;
    gf out; GAS unsigned char* ws; int bx, G;
};

__device__ __forceinline__ void conv_layer(const Ptrs& P, int l, LAS unsigned char* lds, int tid, int wid, int lane) {
    gb Wd = (gb)(P.ws + WS_W0 + (size_t)(l & 1) * WS_WSZ);
    LAS float* scr = (LAS float*)(lds + wid * 16384);
    const int gw = P.bx * 8 + wid, NGW = P.G * 8;
    const int kind = l % 3, j = l / 3;
    gcf fin0 = P.w_ffn_in + (size_t)(l * 2 + 0) * DM * 2 * DFF, fin1 = P.w_ffn_in + (size_t)(l * 2 + 1) * DM * 2 * DFF;
    gcf fo0 = P.w_ffn_out + (size_t)(l * 2 + 0) * DFF * DM, fo1 = P.w_ffn_out + (size_t)(l * 2 + 1) * DFF * DM;
    gb mix = Wd + OFF_MIX;
    for (int it = gw; it < 16384; it += NGW) {
        int r = it;
        if (conv_job(r, fin0, DM, 2 * DFF, 1, Wd + OFF_WIN0, Wd, 0, scr, lane)) continue;
        if (conv_job(r, fo0, DFF, DM, 0, Wd + OFF_WOUT0, Wd, 0, scr, lane)) continue;
        if (conv_job(r, fin1, DM, 2 * DFF, 1, Wd + OFF_WIN1, Wd, 0, scr, lane)) continue;
        if (conv_job(r, fo1, DFF, DM, 0, Wd + OFF_WOUT1, Wd, 0, scr, lane)) continue;
        if (kind == 0) {
            if (conv_job(r, P.a_w_in + (size_t)j * DM * 704, DM, 704, 0, mix + MLA_WA, mix, 0, scr, lane)) continue;
            if (conv_job(r, P.a_w_qb + (size_t)j * 384 * 1536, 384, 1536, 0, mix + MLA_WQB, mix, 0, scr, lane)) continue;
            if (conv_job(r, P.a_w_kvb + (size_t)j * 256 * 2048, 256, 2048, 3, mix + MLA_WKN, mix + MLA_WVT, 0, scr, lane)) continue;
            if (conv_job(r, P.a_w_o + (size_t)j * DM * DM, DM, DM, 0, mix + MLA_WO, mix, 0, scr, lane)) continue;
        } else if (kind == 1) {
            if (conv_job(r, P.b_w_qkv, DM, 3072, 2, mix + DIF_WQK, mix + DIF_WV, 2048, scr, lane)) continue;
            if (conv_job(r, P.b_w_o, DM, DM, 0, mix + DIF_WO, mix, 0, scr, lane)) continue;
        } else {
            if (conv_job(r, P.c_w_qkv, DM, 1536, 2, mix + SWA_WQK, mix + SWA_WV, 1280, scr, lane)) continue;
            if (conv_job(r, P.c_w_o, DM, DM, 0, mix + SWA_WO, mix, 0, scr, lane)) continue;
        }
        break;
    }
    if (kind == 0) {
        const int gt = P.bx * 512 + tid, NT = P.G * 512;
        for (int i = gt; i < 8192; i += NT) { const unsigned zz = __float_as_uint(opaque_zero()); *(GAS u32x4*)(mix + MLA_WA + (size_t)704 * DM + (size_t)i * 8) = (u32x4){zz, zz, zz, zz}; }
    }
}

__device__ __forceinline__ void sincos_d(double a, float& c, float& s) {
    const double TWO_PI = 6.283185307179586476925286766559;
    const double k = __builtin_rint(a / TWO_PI); const double r = a - k * TWO_PI, r2 = r * r;
    double ts = r, ss = r, tc = 1.0, cc = 1.0;
#pragma unroll
    for (int i = 1; i <= 14; ++i) { tc *= -r2 / (double)((2 * i - 1) * (2 * i)); cc += tc; ts *= -r2 / (double)((2 * i) * (2 * i + 1)); ss += ts; }
    c = (float)cc; s = (float)ss;
}
__device__ __forceinline__ void prologue(const Ptrs& P, LAS unsigned char* lds, int tid, int wid, int lane) {
    if (P.bx == 0) {
        gf tab = (gf)(P.ws + WS_TAB);
        for (int idx = tid; idx < 1024; idx += 512) { const int pos = idx >> 4, i = idx & 15; const float ang = (float)pos * INVF[i]; float c, s; sincos_d((double)ang, c, s); tab[idx * 2] = c; tab[idx * 2 + 1] = s; }
    }
    LAS float* sS = (LAS float*)lds;
    LAS float* red = (LAS float*)(lds + 49152);
    for (int idx = tid; idx < 9 * DM; idx += 512) { const int b = idx >> 10, k = idx & 1023; const float v = b < 8 ? P.c[b * DM + k] : P.c_ctx[k]; sS[k * 12 + b] = v / (1.0f + __expf(-v)); }
    __syncthreads();
    gf mods = (gf)(P.ws + WS_MODS);
    for (int u = P.bx; u < 4 * 72; u += P.G) {
        const int l = u / 72, n0 = (u % 72) * 128;
        gcf wp = P.w_mod + ((size_t)l * DM + wid * 128) * NMODC + n0 + 2 * lane;
        float acc[9][2];
#pragma unroll
        for (int b = 0; b < 9; ++b) { acc[b][0] = 0.f; acc[b][1] = 0.f; }
#pragma unroll 8
        for (int k = 0; k < 128; ++k) {
            const f32x2 w = *(const GAS f32x2*)(wp + (size_t)k * NMODC);
            const LAS f32x4* sp = (const LAS f32x4*)(sS + (wid * 128 + k) * 12);
            const f32x4 s0 = sp[0], s1 = sp[1], s2 = sp[2];
            acc[0][0] += s0[0] * w[0]; acc[0][1] += s0[0] * w[1]; acc[1][0] += s0[1] * w[0]; acc[1][1] += s0[1] * w[1];
            acc[2][0] += s0[2] * w[0]; acc[2][1] += s0[2] * w[1]; acc[3][0] += s0[3] * w[0]; acc[3][1] += s0[3] * w[1];
            acc[4][0] += s1[0] * w[0]; acc[4][1] += s1[0] * w[1]; acc[5][0] += s1[1] * w[0]; acc[5][1] += s1[1] * w[1];
            acc[6][0] += s1[2] * w[0]; acc[6][1] += s1[2] * w[1]; acc[7][0] += s1[3] * w[0]; acc[7][1] += s1[3] * w[1];
            acc[8][0] += s2[0] * w[0]; acc[8][1] += s2[0] * w[1];
        }
#pragma unroll
        for (int b = 0; b < 9; ++b) { red[(wid * 9 + b) * 128 + 2 * lane] = acc[b][0]; red[(wid * 9 + b) * 128 + 2 * lane + 1] = acc[b][1]; }
        __syncthreads();
        for (int idx = tid; idx < 9 * 128; idx += 512) { const int b = idx >> 7, n = idx & 127; float s = 0.f;
#pragma unroll
            for (int w = 0; w < 8; ++w) s += red[(w * 9 + b) * 128 + n];
            mods[((size_t)l * 9 + b) * NMODC + n0 + n] = s + P.b_mod[(size_t)l * NMODC + n0 + n]; }
        __syncthreads();
    }
    __syncthreads();
    conv_layer(P, 0, lds, tid, wid, lane);
}

__device__ __forceinline__ void norm_phase(const Ptrs& P, int l, int which, int wid, int lane) {
    const bool from_in = (l == 0 && which == 0);
    gcf X = (gcf)(P.ws + WS_X);
    gcf slat = from_in ? P.x : X, sctx = from_in ? P.ctx : X + (size_t)MLAT * DM;
    gb Hn = (gb)(P.ws + WS_HN);
    gcf g = P.g_norm + (size_t)(l * 3 + which) * DM;
    gcf mods = (gcf)(P.ws + WS_MODS) + (size_t)l * 9 * NMODC + (size_t)(3 * which) * DM;
    const int M = (l == 3 && which == 2) ? MLAT : MTOT;
    const int gw = P.bx * 8 + wid, NGW = P.G * 8;
    const bool pend = !from_in && which != 2;
    const int pl = which == 0 ? l - 1 : l, pidx = which == 0 ? 8 : (which == 1 ? 2 : 5);
    const float pgsc = which == 2 ? 1.0f : 0.5f;
    gcf pgate = (gcf)(P.ws + WS_MODS) + ((size_t)(pend ? pl : 0) * 9 + 8) * NMODC + (size_t)pidx * DM;
    gcf part = (gcf)(P.ws + WS_S + S_PART);
    f32x4 gg[4];
#pragma unroll
    for (int j = 0; j < 4; ++j) gg[j] = ((const GAS f32x4*)g)[lane + 64 * j];
    f32x4 vn[4];
#define NORM_XR(r) ((const GAS f32x4*)((r) < MLAT ? slat + (size_t)(r) * DM : sctx + (size_t)((r) - MLAT) * DM) + lane)
    if (gw < M) { const GAS f32x4* xr0 = NORM_XR(gw);
#pragma unroll
        for (int j = 0; j < 4; ++j) vn[j] = xr0[64 * j]; }
    int bcur = -1; f32x4 shv[4], scv[4];
#pragma unroll
    for (int j = 0; j < 4; ++j) { shv[j] = (f32x4){0.f, 0.f, 0.f, 0.f}; scv[j] = (f32x4){0.f, 0.f, 0.f, 0.f}; }
    for (int row = gw; row < M; row += NGW) {
        const int b = row < MLAT ? (row >> 12) : 8;
        if (b != bcur) { bcur = b;
#pragma unroll
            for (int j = 0; j < 4; ++j) { shv[j] = ((const GAS f32x4*)(mods + (size_t)b * NMODC))[lane + 64 * j]; scv[j] = ((const GAS f32x4*)(mods + (size_t)b * NMODC + DM))[lane + 64 * j] + 1.0f; } }
        f32x4 v[4]; float s = 0.f;
#pragma unroll
        for (int j = 0; j < 4; ++j) v[j] = vn[j];
        if (row + NGW < M) { const GAS f32x4* xr1 = NORM_XR(row + NGW);
#pragma unroll
            for (int j = 0; j < 4; ++j) vn[j] = xr1[64 * j]; }
#pragma unroll
        for (int j = 0; j < 4; ++j) s += (v[j][0] * v[j][0] + v[j][1] * v[j][1]) + (v[j][2] * v[j][2] + v[j][3] * v[j][3]);
        if (from_in) { GAS f32x4* xo = (GAS f32x4*)(P.ws + WS_X + (size_t)row * DM * 4) + lane;
#pragma unroll
            for (int j = 0; j < 4; ++j) xo[64 * j] = v[j]; }
        else if (pend && row >= MLAT) { GAS f32x4* xo = (GAS f32x4*)(P.ws + WS_X + (size_t)row * DM * 4) + lane; s = 0.f;
#pragma unroll
            for (int j = 0; j < 4; ++j) { f32x4 a = {0.f, 0.f, 0.f, 0.f};
#pragma unroll
                for (int p = 0; p < 8; ++p) a += ((const GAS f32x4*)(part + ((size_t)p * 2048 + (row - MLAT)) * DM))[lane + 64 * j];
                v[j] = v[j] + (((const GAS f32x4*)pgate)[lane + 64 * j] * pgsc) * a; xo[64 * j] = v[j];
                s += (v[j][0] * v[j][0] + v[j][1] * v[j][1]) + (v[j][2] * v[j][2] + v[j][3] * v[j][3]); } }
        const float rstd = 1.0f / sqrtf(wave_sum(s) * (1.0f / DM) + EPS);
        GAS u32x2* o8 = (GAS u32x2*)(Hn + (size_t)row * DM) + lane;
#pragma unroll
        for (int j = 0; j < 4; ++j) { const f32x4 hv = (v[j] * rstd) * gg[j] * scv[j] + shv[j];
            u32x2 w; w.x = pk2(hv[0], hv[1]); w.y = pk2(hv[2], hv[3]); o8[64 * j] = w; }
    }
#undef NORM_XR
}
__device__ __forceinline__ void mla_row_phase(const Ptrs& P, int l, int wid, int lane) {
    const int j = l / 3;
    gcf A = (gcf)(P.ws + WS_S + S_A); gb cqn = (gb)(P.ws + WS_S + S_CQN), ckvn = (gb)(P.ws + WS_S + S_CKVN), kr = (gb)(P.ws + WS_S + S_KR);
    gcf gq = P.a_g_q + (size_t)j * 384, gkv = P.a_g_kv + (size_t)j * 256; gcf tab = (gcf)(P.ws + WS_TAB);
    const int gw = P.bx * 8 + wid, NGW = P.G * 8;
    for (int row = gw; row < MTOT; row += NGW) {
        gcf a = A + (size_t)row * 768;
        f32x2 q[3]; float s = 0.f;
#pragma unroll
        for (int i = 0; i < 3; ++i) { q[i] = *(const GAS f32x2*)(a + 2 * lane + 128 * i); s += q[i][0] * q[i][0] + q[i][1] * q[i][1]; }
        const float rq = 1.0f / sqrtf(wave_sum(s) * (1.0f / 384.0f) + EPS);
#pragma unroll
        for (int i = 0; i < 3; ++i) { const f32x2 g2 = *(const GAS f32x2*)(gq + 2 * lane + 128 * i); *(GAS unsigned*)(cqn + (size_t)row * 384 + 2 * lane + 128 * i) = pk2(q[i][0] * rq * g2[0], q[i][1] * rq * g2[1]); }
        const f32x4 kv = *(const GAS f32x4*)(a + 384 + 4 * lane);
        const float rk = 1.0f / sqrtf(wave_sum((kv[0] * kv[0] + kv[1] * kv[1]) + (kv[2] * kv[2] + kv[3] * kv[3])) * (1.0f / 256.0f) + EPS);
        { const f32x4 g4 = *(const GAS f32x4*)(gkv + 4 * lane); u32x2 w; w.x = pk2(kv[0] * rk * g4[0], kv[1] * rk * g4[1]); w.y = pk2(kv[2] * rk * g4[2], kv[3] * rk * g4[3]); *(GAS u32x2*)(ckvn + (size_t)row * 256 + 4 * lane) = w; }
        const float mine = a[640 + lane]; const float other = __int_as_float(__builtin_amdgcn_ds_bpermute((lane ^ 16) << 2, __float_as_int(mine)));
        float outv = mine;
        if (row < MLAT) { const int t = row & (SEQ - 1), axis = lane >> 5, pos = axis ? (t & 63) : (t >> 6), i = lane & 15;
            const float c = tab[(pos * 16 + i) * 2], sn = tab[(pos * 16 + i) * 2 + 1];
            outv = (lane & 16) ? (mine * c + other * sn) : (mine * c - other * sn); }
        kr[(size_t)row * 64 + lane] = (bf16_t)f2bf(outv);
    }
}
__device__ __forceinline__ void diff_row_phase(const Ptrs& P, int wid, int lane) {
    gcb O2 = (gcb)(P.ws + WS_S + S_O2); gb On = (gb)(P.ws + WS_HN);
    gcf lp = P.b_lambda;
    const float lam = __expf(wave_sum(lp[lane] * lp[64 + lane])) - __expf(wave_sum(lp[128 + lane] * lp[192 + lane])) + LAM_INIT;
    const int sub = lane & 15, hq = lane >> 4;
    const f32x4 ga = *(const GAS f32x4*)(P.b_g_sub + 8 * sub), gb4 = *(const GAS f32x4*)(P.b_g_sub + 8 * sub + 4);
    const int gw = P.bx * 8 + wid, NGW = P.G * 8;
    for (int row = gw; row < MTOT; row += NGW) {
#pragma unroll
        for (int it = 0; it < 2; ++it) { const int h = hq + 4 * it;
            const u32x4 av = *(const GAS u32x4*)(O2 + (size_t)row * 2048 + (2 * h) * 128 + 8 * sub), bv = *(const GAS u32x4*)(O2 + (size_t)row * 2048 + (2 * h + 1) * 128 + 8 * sub);
            float d[8]; float ss = 0.f;
#pragma unroll
            for (int e = 0; e < 4; ++e) { d[2 * e] = __uint_as_float(av[e] << 16) - lam * __uint_as_float(bv[e] << 16); d[2 * e + 1] = __uint_as_float(av[e] & 0xffff0000u) - lam * __uint_as_float(bv[e] & 0xffff0000u);
                ss += d[2 * e] * d[2 * e] + d[2 * e + 1] * d[2 * e + 1]; }
#pragma unroll
            for (int o = 1; o < 16; o <<= 1) ss += __int_as_float(__builtin_amdgcn_ds_bpermute((lane ^ o) << 2, __float_as_int(ss)));
            const float r = 1.0f / sqrtf(ss * (1.0f / 128.0f) + EPS) * (1.0f - LAM_INIT);
            u32x4 w; w.x = pk2(d[0] * r * ga[0], d[1] * r * ga[1]); w.y = pk2(d[2] * r * ga[2], d[3] * r * ga[3]); w.z = pk2(d[4] * r * gb4[0], d[5] * r * gb4[1]); w.w = pk2(d[6] * r * gb4[2], d[7] * r * gb4[3]);
            *(GAS u32x4*)(On + (size_t)row * DM + h * 128 + 8 * sub) = w;
        }
    }
}
__device__ __forceinline__ void final_phase(const Ptrs& P, int wid, int lane) {
    gcf X = (gcf)(P.ws + WS_X);
    const int gw = P.bx * 8 + wid, NGW = P.G * 8;
    f32x4 gg[4];
#pragma unroll
    for (int j = 0; j < 4; ++j) gg[j] = ((const GAS f32x4*)P.g_final)[lane + 64 * j];
    f32x4 vn[4];
    if (gw < MLAT) { const GAS f32x4* xr0 = (const GAS f32x4*)(X + (size_t)gw * DM) + lane;
#pragma unroll
        for (int j = 0; j < 4; ++j) vn[j] = xr0[64 * j]; }
    for (int row = gw; row < MLAT; row += NGW) {
        f32x4 v[4]; float s = 0.f;
#pragma unroll
        for (int j = 0; j < 4; ++j) v[j] = vn[j];
        if (row + NGW < MLAT) { const GAS f32x4* xr1 = (const GAS f32x4*)(X + (size_t)(row + NGW) * DM) + lane;
#pragma unroll
            for (int j = 0; j < 4; ++j) vn[j] = xr1[64 * j]; }
#pragma unroll
        for (int j = 0; j < 4; ++j) s += (v[j][0] * v[j][0] + v[j][1] * v[j][1]) + (v[j][2] * v[j][2] + v[j][3] * v[j][3]);
        const float rstd = 1.0f / sqrtf(wave_sum(s) * (1.0f / DM) + EPS);
        GAS f32x4* op = (GAS f32x4*)(P.out + (size_t)row * DM) + lane;
#pragma unroll
        for (int j = 0; j < 4; ++j) op[64 * j] = (v[j] * rstd) * gg[j];
    }
}

template <int DQK, int DV, bool MLA, bool WINDOW, bool SINK>
__device__ __forceinline__ void attn_phase(LAS unsigned char* lds, gcb Q, int ldq, gcb K, int ldk, gcb Kr, gcb Vt, gb O, int ldo, int nheads, int kdiv, int vdiv, gcf sink, bool with_ctx_q, int vcu, int G) {
    constexpr int KCH = DQK / 8, KCHP = KCH + 1, KSTR = KCHP * 16, VCHP = 9, VSTR = VCHP * 16, KBUF = 64 * KSTR, VBUF = DV * VSTR;
    constexpr int KINST = KCHP, VINST = (DV * VCHP) / 64;
    constexpr int NDC = DQK / 16, NDVB = DV / 32, NKI = (KINST + 7) / 8, NVI = (VINST + 7) / 8;
    constexpr int NDMA = KINST / 8 + VINST / 8;
    LAS unsigned char* ldsK = lds; LAS unsigned char* ldsV = lds + 3 * KBUF;
    static_assert(3 * (KBUF + VBUF) <= 140 * 1024, "attention LDS ring");
    int tid_ = threadIdx.x; asm volatile("" : "+v"(tid_));
    const int tid = tid_, lane = tid & 63, r32 = lane & 31, hi = lane >> 5, wid = __builtin_amdgcn_readfirstlane(tid >> 6);
    const int nlat = NB * nheads * 16, nunits = nlat + (with_ctx_q ? NB * nheads : 0);
    const int pr = (r32 & 0x13) | ((r32 & 4) << 1) | ((r32 & 8) >> 1);
    int kc[NKI], ks[NKI], kh[NKI], vc[NVI];
#pragma unroll
    for (int i = 0; i < NKI; ++i) { const int q = (wid + 8 * i) * 64 + lane, row = q / KCHP, cp = q % KCHP, c = cp < KCH ? cp : 0;
        if (MLA) { if (c < 16) { kc[i] = row * 2048 + c * 16; ks[i] = 2048; kh[i] = 2; } else { kc[i] = (int)((const GAS unsigned char*)Kr - (const GAS unsigned char*)K) + row * 128 + (c - 16) * 16; ks[i] = 128; kh[i] = 0; } }
        else { kc[i] = row * ldk * 2 + c * 16; ks[i] = ldk * 2; kh[i] = 2; } }
#pragma unroll
    for (int i = 0; i < NVI; ++i) { const int q = (wid + 8 * i) * 64 + lane, dv = q / VCHP, cp = q % VCHP, c = cp < 8 ? cp : 0; vc[i] = dv * (MTOT * 2) + c * 16; }
    for (int u = vcu; u < nunits; u += G) {
        int bh, qblk; if (u < nlat) { bh = u >> 4; qblk = u & 15; } else { bh = u - nlat; qblk = 16; }
        const int head = bh % nheads, b = bh / nheads;
        const bool isctx = (qblk == 16);
        const int qrow0 = isctx ? MLAT + b * CTXL : b * SEQ + qblk * 256;
        int lt0 = 0, lt1 = isctx ? 0 : 64;
        if (WINDOW && !isctx) { int lo = qblk * 256 - 128; if (lo < 0) lo = 0; int hh = qblk * 256 + 384; if (hh > SEQ) hh = SEQ; lt0 = lo >> 6; lt1 = hh >> 6; }
        const int NT = 4 + (lt1 - lt0);
        const int kcol = (head / kdiv) * (MLA ? 128 : 64);
        const size_t vrow0 = (size_t)(head / vdiv) * DV;
        bf16x8 qf[NDC];
        { gcb qp = Q + (size_t)(qrow0 + wid * 32 + r32) * ldq + head * DQK + hi * 8;
#pragma unroll
          for (int dc = 0; dc < NDC; ++dc) qf[dc] = *(const GAS bf16x8*)(qp + dc * 16); }
        float m_run = -1e30f, l_run = 0.f;
        if (SINK) { m_run = sink[head] * LOG2E; l_run = hi == 0 ? 1.0f : 0.0f; }
        f32x16 o[NDVB]; const float zatt = opaque_zero();
#pragma unroll
        for (int d = 0; d < NDVB; ++d)
#pragma unroll
            for (int r = 0; r < 16; ++r) o[d][r] = zatt;
#define ATT_DMA(t, bf) do { const int t_ = (t), bf_ = (bf); const int krow_ = t_ < 4 ? MLAT + b * CTXL + 64 * t_ : b * SEQ + 64 * (lt0 + t_ - 4); \
        _Pragma("unroll") for (int i = 0; i < NKI; ++i) if (wid + 8 * i < KINST) { \
            const unsigned off = (unsigned)(kc[i] + kh[i] * kcol + krow_ * ks[i]); \
            __builtin_amdgcn_global_load_lds((const GAS unsigned*)((const GAS unsigned char*)K + off), (LAS unsigned*)(ldsK + bf_ * KBUF + (wid + 8 * i) * 1024), 16, 0, 0); } \
        _Pragma("unroll") for (int i = 0; i < NVI; ++i) if (wid + 8 * i < VINST) { \
            __builtin_amdgcn_global_load_lds((const GAS unsigned*)((const GAS unsigned char*)(Vt + vrow0 * MTOT + krow_) + (unsigned)vc[i]), (LAS unsigned*)(ldsV + bf_ * VBUF + (wid + 8 * i) * 1024), 16, 0, 0); } } while (0)
#define ATT_WAITBAR(N) asm volatile("s_waitcnt vmcnt(%0) lgkmcnt(0)\n\ts_barrier" :: "n"(N) : "memory")
#define ATT_QK(d0, d1, bf_, t_) do { \
            { f32x16 e0_, e1_;     \
            _Pragma("unroll") for (int r = 0; r < 16; ++r) { d0[r] = 0.f; d1[r] = 0.f; e0_[r] = 0.f; e1_[r] = 0.f; } \
            { const LAS unsigned char* kb0 = ldsK + (bf_) * KBUF + pr * KSTR + hi * 16; const LAS unsigned char* kb1 = kb0 + 32 * KSTR; \
              _Pragma("unroll") for (int dc = 0; dc < NDC; dc += 2) { \
                  const bf16x8 k0 = *(const LAS bf16x8*)(kb0 + dc * 32), k1 = *(const LAS bf16x8*)(kb1 + dc * 32), k2 = *(const LAS bf16x8*)(kb0 + dc * 32 + 32), k3 = *(const LAS bf16x8*)(kb1 + dc * 32 + 32); \
                  d0 = __builtin_amdgcn_mfma_f32_32x32x16_bf16(k0, qf[dc], d0, 0, 0, 0); d1 = __builtin_amdgcn_mfma_f32_32x32x16_bf16(k1, qf[dc], d1, 0, 0, 0); \
                  e0_ = __builtin_amdgcn_mfma_f32_32x32x16_bf16(k2, qf[dc + 1], e0_, 0, 0, 0); e1_ = __builtin_amdgcn_mfma_f32_32x32x16_bf16(k3, qf[dc + 1], e1_, 0, 0, 0); } } \
            _Pragma("unroll") for (int r = 0; r < 16; ++r) { d0[r] += e0_[r]; d1[r] += e1_[r]; } } \
            if (WINDOW && (t_) >= 4) { const int kbase = 64 * (lt0 + (t_) - 4) + 8 * hi - (qblk * 256 + wid * 32 + r32); \
                _Pragma("unroll") for (int r = 0; r < 16; ++r) { const int e0 = kbase + 16 * (r >> 3) + (r & 7), e1 = e0 + 32; \
                    if (e0 > 128 || e0 < -128) d0[r] = -1e30f; if (e1 > 128 || e1 < -128) d1[r] = -1e30f; } } } while (0)
        ATT_DMA(0, 0); ATT_DMA(1, 1);
        ATT_WAITBAR(0);
        int buf = 0, buf1 = 1, buf2 = 2;
        constexpr bool PIPE = false;
        f32x16 s0, s1;
        if (PIPE) ATT_QK(s0, s1, 0, 0);
#pragma unroll 1
        for (int t = 0; t < NT; ++t) {
            if (t + 2 < NT) ATT_DMA(t + 2, buf2);
            f32x16 n0, n1;
            if (PIPE) ATT_QK(n0, n1, buf1, t + 1);
            else ATT_QK(s0, s1, buf, t);
            float mxa = fmaxf(s0[0], s1[0]), mxb = fmaxf(s0[1], s1[1]), mxc = fmaxf(s0[2], s1[2]), mxd = fmaxf(s0[3], s1[3]);
#pragma unroll
            for (int r = 4; r < 16; r += 4) { mxa = fmaxf(mxa, fmaxf(s0[r], s1[r])); mxb = fmaxf(mxb, fmaxf(s0[r + 1], s1[r + 1])); mxc = fmaxf(mxc, fmaxf(s0[r + 2], s1[r + 2])); mxd = fmaxf(mxd, fmaxf(s0[r + 3], s1[r + 3])); }
            float mx = half_max(fmaxf(fmaxf(mxa, mxb), fmaxf(mxc, mxd)));
            if (__builtin_amdgcn_ballot_w64(mx - m_run > 8.0f) != 0ull) {
                const float m_new = fmaxf(m_run, mx), alpha = fast_exp2(m_run - m_new); m_run = m_new; l_run *= alpha;
#pragma unroll
                for (int d = 0; d < NDVB; ++d)
#pragma unroll
                    for (int r = 0; r < 16; ++r) o[d][r] *= alpha;
            }
            float lsa = 0.f, lsb = 0.f, lsc = 0.f, lsd = 0.f;
#pragma unroll
            for (int r = 0; r < 16; r += 2) { s0[r] = fast_exp2(s0[r] - m_run); s1[r] = fast_exp2(s1[r] - m_run); s0[r + 1] = fast_exp2(s0[r + 1] - m_run); s1[r + 1] = fast_exp2(s1[r + 1] - m_run);
                lsa += s0[r]; lsb += s1[r]; lsc += s0[r + 1]; lsd += s1[r + 1]; }
            l_run += (lsa + lsb) + (lsc + lsd);
            bf16x8 pf[4];
            { u32x4 w;
              w.x = pk2(s0[0], s0[1]); w.y = pk2(s0[2], s0[3]); w.z = pk2(s0[4], s0[5]); w.w = pk2(s0[6], s0[7]); pf[0] = __builtin_bit_cast(bf16x8, w);
              w.x = pk2(s0[8], s0[9]); w.y = pk2(s0[10], s0[11]); w.z = pk2(s0[12], s0[13]); w.w = pk2(s0[14], s0[15]); pf[1] = __builtin_bit_cast(bf16x8, w);
              w.x = pk2(s1[0], s1[1]); w.y = pk2(s1[2], s1[3]); w.z = pk2(s1[4], s1[5]); w.w = pk2(s1[6], s1[7]); pf[2] = __builtin_bit_cast(bf16x8, w);
              w.x = pk2(s1[8], s1[9]); w.y = pk2(s1[10], s1[11]); w.z = pk2(s1[12], s1[13]); w.w = pk2(s1[14], s1[15]); pf[3] = __builtin_bit_cast(bf16x8, w); }
            { const LAS unsigned char* vb = ldsV + buf * VBUF + r32 * VSTR + hi * 16;
#pragma unroll
              for (int c = 0; c < 4; ++c)
#pragma unroll
                  for (int d = 0; d < NDVB; ++d) { const bf16x8 vf = *(const LAS bf16x8*)(vb + d * 32 * VSTR + c * 32); o[d] = __builtin_amdgcn_mfma_f32_32x32x16_bf16(vf, pf[c], o[d], 0, 0, 0); } }
            if (PIPE || t + 2 >= NT) ATT_WAITBAR(0); else ATT_WAITBAR(NDMA);
            if (PIPE) { s0 = n0; s1 = n1; }
            buf = buf1; buf1 = buf2; buf2 = buf2 == 2 ? 0 : buf2 + 1;
        }
#undef ATT_QK
#undef ATT_DMA
#undef ATT_WAITBAR
        const float inv = 1.0f / half_sum(l_run);
        gb op = O + (size_t)(qrow0 + wid * 32 + r32) * ldo + head * DV + 8 * hi;
#pragma unroll
        for (int d = 0; d < NDVB; ++d)
#pragma unroll
            for (int p = 0; p < 2; ++p) {
                const unsigned ax = pk2(o[d][8 * p] * inv, o[d][8 * p + 1] * inv), ay = pk2(o[d][8 * p + 2] * inv, o[d][8 * p + 3] * inv);
                const unsigned bx = pk2(o[d][8 * p + 4] * inv, o[d][8 * p + 5] * inv), by = pk2(o[d][8 * p + 6] * inv, o[d][8 * p + 7] * inv);
                const auto r1 = __builtin_amdgcn_permlane32_swap(ax, bx, false, false), r2 = __builtin_amdgcn_permlane32_swap(ay, by, false, false);
                u32x4 w; w.x = r1[0]; w.y = r2[0]; w.z = r1[1]; w.w = r2[1];
                *(GAS u32x4*)(op + 32 * d + 16 * p) = w; }
    }
}

#define XB_TMO      128
#define XB_XCNT(j)  (256  + 64 * (j))
#define XB_XSUB(j)  (1280 + 64 * (j))
#define XB_XGEN(j)  (2304 + 64 * (j))
#define XB_TOP      3328
#define XB_TOPGEN   3392
#define XCD_BAR_WORDS 3456
#define XB_SPIN_CAP (1u << 21)

__device__ __forceinline__ unsigned xb_ld(unsigned* p)              { return __hip_atomic_load(p, __ATOMIC_RELAXED, __HIP_MEMORY_SCOPE_AGENT); }
__device__ __forceinline__ unsigned xb_add(unsigned* p, unsigned v) { return __hip_atomic_fetch_add(p, v, __ATOMIC_RELAXED, __HIP_MEMORY_SCOPE_AGENT); }
__device__ __forceinline__ unsigned xb_xcc_id() { return (unsigned)__builtin_amdgcn_s_getreg((3 << 11) | 20) & 0xFu; }
#define XB_SPIN(cond, bar) do { unsigned _sp = 0; while (cond) { __builtin_amdgcn_s_sleep(1); \
    if ((++_sp & 255u) == 0u) { if (xb_ld(&(bar)[XB_TMO])) break; if (_sp > XB_SPIN_CAP) { atomicAdd(&(bar)[XB_TMO], 1u); break; } } } } while (0)

struct XcdBarrier {
    unsigned* bar; unsigned x;
    volatile LAS unsigned* st;
};

__device__ __forceinline__ XcdBarrier xcd_barrier_post(unsigned* bar, volatile LAS unsigned* st) {
    XcdBarrier b; b.bar = bar; b.x = xb_xcc_id(); b.st = st;
    if (threadIdx.x == 0) (void)xb_add(&bar[XB_XCNT(b.x)], 1u);
    return b;
}
__device__ __forceinline__ void xcd_barrier_complete(unsigned* bar, unsigned x, unsigned& nloc, unsigned& nx) {
    const unsigned G = gridDim.x * gridDim.y * gridDim.z;
    unsigned sum, cnt, mine, sp = 0u;
    for (;;) {
        sum = 0u; cnt = 0u; mine = 0u;
#pragma unroll
        for (unsigned j = 0; j < 16; ++j) { const unsigned c = xb_ld(&bar[XB_XCNT(j)]); sum += c; cnt += (c > 0u) ? 1u : 0u; mine = (j == x) ? c : mine; }
        if (sum == G) break;
        __builtin_amdgcn_s_sleep(1);
        if ((++sp & 255u) == 0u) { if (xb_ld(&bar[XB_TMO])) break; if (sp > XB_SPIN_CAP) { atomicAdd(&bar[XB_TMO], 1u); break; } }
    }
    nloc = mine > 0u ? mine : 1u; nx = cnt > 0u ? cnt : 1u;
}

__device__ __forceinline__ void xcd_barrier(const XcdBarrier& b) {
    asm volatile("s_waitcnt vmcnt(0)" ::: "memory");
    __syncthreads();
    if (threadIdx.x == 0) {
        unsigned* bar = b.bar;
        __builtin_amdgcn_s_waitcnt(0);
        unsigned nloc = b.st[0], nx = b.st[1];
        if (nloc == 0u) { xcd_barrier_complete(bar, b.x, nloc, nx); b.st[0] = nloc; b.st[1] = nx; }
        const unsigned old = xb_add(&bar[XB_XSUB(b.x)], 1u);
        const unsigned gen = old / nloc;
        if (old + 1u == (gen + 1u) * nloc) {
            __builtin_amdgcn_fence(__ATOMIC_RELEASE, "agent");
            asm volatile("s_waitcnt vmcnt(0)" ::: "memory");
            const unsigned og = xb_add(&bar[XB_TOP], 1u);
            const unsigned tg = og / nx;
            if (og + 1u == (tg + 1u) * nx) xb_add(&bar[XB_TOPGEN], 1u);
            else XB_SPIN(xb_ld(&bar[XB_TOPGEN]) == tg, bar);
            __builtin_amdgcn_fence(__ATOMIC_ACQUIRE, "agent");
            xb_add(&bar[XB_XGEN(b.x)], 1u);
            asm volatile("s_waitcnt vmcnt(0)" ::: "memory");
        } else {
            XB_SPIN(xb_ld(&bar[XB_XGEN(b.x)]) == gen, bar);
            __builtin_amdgcn_fence(__ATOMIC_ACQUIRE, "agent");
            asm volatile("s_waitcnt vmcnt(0)" ::: "memory");
        }
    }
    __syncthreads();
}

#define KARG(i) ((gcf)(*(const __attribute__((address_space(4))) unsigned long long*)(kp + 8 * (i))))
#define PHASE_BEGIN int tid_ = threadIdx.x; asm volatile("" : "+v"(tid_)); const int tid = tid_, lane = tid & 63, wid = __builtin_amdgcn_readfirstlane(tid >> 6); const __attribute__((address_space(4))) unsigned char* kp = (const __attribute__((address_space(4))) unsigned char*)__builtin_amdgcn_kernarg_segment_ptr(); asm volatile("" : "+s"(kp)); int G = gridDim.x, bx = __builtin_amdgcn_readfirstlane((int)MISC[5]); asm volatile("" : "+s"(G), "+s"(bx)); const int vcu = __builtin_amdgcn_readfirstlane((int)MISC[4]); Ptrs P; P.bx = bx; P.G = G; P.x = KARG(0); P.c = KARG(1); P.ctx = KARG(2); P.c_ctx = KARG(3); P.w_mod = KARG(4); P.b_mod = KARG(5); P.g_norm = KARG(6); P.w_ffn_in = KARG(7); P.w_ffn_out = KARG(8); P.a_w_in = KARG(9); P.a_g_q = KARG(10); P.a_g_kv = KARG(11); P.a_w_qb = KARG(12); P.a_w_kvb = KARG(13); P.a_w_o = KARG(14); P.b_w_qkv = KARG(15); P.b_lambda = KARG(16); P.b_g_sub = KARG(17); P.b_w_o = KARG(18); P.c_w_qkv = KARG(19); P.c_sink = KARG(20); P.c_w_o = KARG(21); P.g_final = KARG(22); P.out = (gf)KARG(23); P.ws = (GAS unsigned char*)KARG(24);
struct Args { const float* in[23]; float* out; unsigned char* ws; int ph_lo, ph_hi; };

__global__ void __launch_bounds__(512, 2) fwd_kernel(Args args) {
    extern __shared__ __attribute__((aligned(16))) unsigned char lds_raw[];
    LAS unsigned char* lds = (LAS unsigned char*)lds_raw;
    cg::grid_group grid = cg::this_grid();
    volatile LAS unsigned* MISC = (volatile LAS unsigned*)(lds + 143360 + 512);
    if (threadIdx.x < 8) MISC[threadIdx.x] = 0u;
    __syncthreads();
    if (threadIdx.x == 0) {
        const unsigned x = xb_xcc_id(); unsigned* bar0 = (unsigned*)(args.ws + WS_BAR);
        const unsigned rank = xb_add(&bar0[XB_XCNT(x)], 1u);
        const unsigned G0 = gridDim.x, bx0 = blockIdx.x;
        MISC[2] = rank; MISC[3] = x; MISC[4] = (G0 % 8 == 0) ? (bx0 % 8) * (G0 / 8) + bx0 / 8 : bx0; MISC[5] = bx0;
    }
    __syncthreads();

    for (int ph = args.ph_lo; ph < args.ph_hi; ++ph) {
        const unsigned pw = __builtin_amdgcn_readfirstlane(PROG_D.e[ph]);
        const int op = pw & 0xff, l = (pw >> 8) & 0xff, sraw = (pw >> 16) & 0xff, s = sraw & 3, rep = sraw >> 7;
#ifdef ONLY_OP
        if (op != ONLY_OP) continue;
#endif
        const int kind = l % 3;
#ifdef ONLY_KIND
        if (kind != ONLY_KIND) continue;
#endif
#define PHASE_LOCALS gcb Wl = (gcb)(P.ws + WS_W0 + (size_t)(l & 1) * WS_WSZ); gcb HN = (gcb)(P.ws + WS_HN); GAS unsigned char* Sb = P.ws + WS_S; gcf tab = (gcf)(P.ws + WS_TAB); gcf modl = (gcf)(P.ws + WS_MODS) + (size_t)l * 9 * NMODC; gf X = (gf)(P.ws + WS_X); \
        (void)Wl; (void)HN; (void)Sb; (void)tab; (void)modl; (void)X; (void)tid; (void)lane; (void)wid; (void)vcu;
        switch (op) {
        case OP_PRO: { PHASE_BEGIN PHASE_LOCALS prologue(P, lds, tid, wid, lane); } break;
        case OP_NORM: { PHASE_BEGIN PHASE_LOCALS
            norm_phase(P, l, s, wid, lane);
            if (s == 0 && l + 1 < 4) conv_layer(P, l + 1, lds, tid, wid, lane);
        } break;
        case OP_FFN_IN: { PHASE_BEGIN PHASE_LOCALS
            const int M = (l == 3 && s == 1) ? MLAT : MTOT;
            EpiSwiglu E{(gb)(Sb + S_HH)};
            run_gemm(lds, G, bx, HN, Wl + (s ? OFF_WIN1 : OFF_WIN0), M, 2 * DFF, DM, E);
        } break;
        case OP_FFN_OUT: case OP_MIX_OUT: { PHASE_BEGIN PHASE_LOCALS
            const bool ffn = (op == OP_FFN_OUT);
            const int M = (l == 3 && (!ffn || s == 1)) ? MLAT : MTOT;
            EpiResid E{(gcf)X, (gcf)(X + (size_t)MLAT * DM), X, modl + (size_t)(ffn ? (s ? 8 : 2) : 5) * DM, rep ? 0u : (ffn ? 0x3f000000u : 0x3f800000u)};
            gcb A = ffn ? (gcb)(Sb + S_HH) : HN;
            gcb Bt = ffn ? Wl + (s ? OFF_WOUT1 : OFF_WOUT0) : Wl + OFF_MIX + (kind == 0 ? MLA_WO : kind == 1 ? DIF_WO : SWA_WO);
            run_gemm(lds, G, bx, A, Bt, M, DM, ffn ? DFF : DM, E, ffn && (!rep || PROBE_SKIP_EPI));
        } break;
        case OP_MLA_IN: { PHASE_BEGIN PHASE_LOCALS
            EpiF32 E{(gf)(Sb + S_A), 768};
            run_gemm(lds, G, bx, HN, Wl + OFF_MIX + MLA_WA, MTOT, 768, DM, E);
        } break;
        case OP_MLA_ROW: { PHASE_BEGIN PHASE_LOCALS mla_row_phase(P, l, wid, lane); } break;
        case OP_PROJ: { PHASE_BEGIN PHASE_LOCALS
            if (kind == 0) {
                { EpiRope E{(gb)(Sb + S_Q), 1536, 192, 128, 1536, 0.07216878364870322f * LOG2E, tab};
                  run_gemm(lds, G, bx, (gcb)(Sb + S_CQN), Wl + OFF_MIX + MLA_WQB, MTOT, 1536, 384, E); }
                { EpiStoreBf16 E{(gb)(Sb + S_KN), 1024};
                  run_gemm(lds, G, bx, (gcb)(Sb + S_CKVN), Wl + OFF_MIX + MLA_WKN, MTOT, 1024, 256, E); }
                { EpiStoreBf16 E{(gb)(Sb + S_VT_MLA), MTOT};
                  run_gemm(lds, G, bx, Wl + OFF_MIX + MLA_WVT, (gcb)(Sb + S_CKVN), 1024, MTOT, 256, E); }
            } else {
                const int nqk = kind == 1 ? 2048 : 1280, nv = kind == 1 ? 1024 : 256;
                { EpiRope E{(gb)(Sb + S_QK), nqk, 64, 0, 1024, 0.125f * LOG2E, tab};
                  run_gemm(lds, G, bx, HN, Wl + OFF_MIX + (kind == 1 ? DIF_WQK : SWA_WQK), MTOT, nqk, DM, E); }
                { EpiStoreBf16 E{(gb)(Sb + (kind == 1 ? S_VT_DIFF : S_VT_SWA)), MTOT};
                  run_gemm(lds, G, bx, Wl + OFF_MIX + (kind == 1 ? DIF_WV : SWA_WV), HN, nv, MTOT, DM, E); }
            }
        } break;
        case OP_ATT: { PHASE_BEGIN PHASE_LOCALS
            if (kind == 0)
                attn_phase<192, 128, true, false, false>(lds, (gcb)(Sb + S_Q), 1536, (gcb)(Sb + S_KN), 1024, (gcb)(Sb + S_KR), (gcb)(Sb + S_VT_MLA), (gb)(P.ws + WS_HN), 1024, 8, 1, 1, P.c_sink, l < 3, vcu, G);
            else if (kind == 1)
                attn_phase<64, 128, false, false, false>(lds, (gcb)(Sb + S_QK), 2048, (gcb)(Sb + S_QK) + 1024, 2048, (gcb)(Sb + S_QK), (gcb)(Sb + S_VT_DIFF), (gb)(Sb + S_O2), 2048, 16, 1, 2, P.c_sink, true, vcu, G);
            else
                attn_phase<64, 64, false, true, true>(lds, (gcb)(Sb + S_QK), 1280, (gcb)(Sb + S_QK) + 1024, 1280, (gcb)(Sb + S_QK), (gcb)(Sb + S_VT_SWA), (gb)(P.ws + WS_HN), 1024, 16, 4, 4, P.c_sink, true, vcu, G);
        } break;
        case OP_DIFF_ROW: { PHASE_BEGIN PHASE_LOCALS diff_row_phase(P, wid, lane); } break;
        case OP_FINAL: { PHASE_BEGIN PHASE_LOCALS final_phase(P, wid, lane); } break;
        default: break;
        }
        __syncthreads();
        if (ph + 1 < args.ph_hi) {
            if (ph == 0) { grid.sync();
                if (threadIdx.x == 0) {
                    unsigned* bar0 = (unsigned*)(args.ws + WS_BAR); const unsigned x = MISC[3], rank = MISC[2], G0 = gridDim.x;
                    unsigned pre = 0u, idx = 0u, nx = 0u; bool uni = true;
                    for (unsigned j = 0; j < 16; ++j) { const unsigned cj = xb_ld(&bar0[XB_XCNT(j)]); if (j < x) { pre += cj; idx += cj ? 1u : 0u; } if (cj) { ++nx; if (cj * 8u != G0) uni = false; } }
                    if (nx == 8u && uni) { MISC[4] = pre + rank; MISC[5] = rank * 8u + idx; }
                }
                __syncthreads(); }
            else { XcdBarrier b; b.bar = (unsigned*)(args.ws + WS_BAR); b.x = xb_xcc_id(); b.st = MISC; xcd_barrier(b); if (DUP_SYNC) xcd_barrier(b); }
        }
    }
}

#ifndef N_LAUNCH_MODE
#define N_LAUNCH_MODE 1
#endif
extern "C" void kernel_launch(void* const* d_in, const int* in_sizes, int n_in, void* d_out, int out_size, void* d_ws, size_t ws_size, hipStream_t stream) {
    static int grid = 0;
    if (grid == 0) {
        if (n_in != 23 || out_size != MLAT * DM || ws_size < WS_END) { fprintf(stderr, "kernel_launch: unexpected problem (n_in %d out %d ws %zu need %zu)\n", n_in, out_size, ws_size, (size_t)WS_END); grid = -1; return; }
        int dev = 0, cus = 0, per_cu = 0;
        hipGetDevice(&dev); hipDeviceGetAttribute(&cus, hipDeviceAttributeMultiprocessorCount, dev);
        if (hipFuncSetAttribute((const void*)fwd_kernel, hipFuncAttributeMaxDynamicSharedMemorySize, LDS_BYTES) != hipSuccess) { fprintf(stderr, "kernel_launch: hipFuncSetAttribute failed\n"); grid = -1; return; }
        if (hipOccupancyMaxActiveBlocksPerMultiprocessor(&per_cu, (const void*)fwd_kernel, 512, LDS_BYTES) != hipSuccess || per_cu < 1) { fprintf(stderr, "kernel_launch: occupancy query gave %d\n", per_cu); per_cu = 1; }
        (void)hipGetLastError();
        grid = cus * 1;
    }
    if (grid < 0) return;
    if (hipMemsetAsync((char*)d_ws + WS_BAR, 0, BAR_ZERO_BYTES, stream) != hipSuccess) { fprintf(stderr, "kernel_launch: memset of barrier words failed\n"); return; }
    Args a{};
    for (int i = 0; i < 23; ++i) a.in[i] = (const float*)d_in[i];
    a.out = (float*)d_out; a.ws = (unsigned char*)d_ws;
#if N_LAUNCH_MODE == 1
    a.ph_lo = 0; a.ph_hi = NPHASE;
    { void* kargs[] = {&a}; hipError_t e = hipLaunchCooperativeKernel((const void*)fwd_kernel, dim3(grid), dim3(512), kargs, LDS_BYTES, stream);
      if (e != hipSuccess) fprintf(stderr, "cooperative launch failed: %s (grid %d)\n", hipGetErrorString(e), grid); }
#else
    for (int ph = 0; ph < NPHASE; ++ph) { a.ph_lo = ph; a.ph_hi = ph + 1; void* kargs[] = {&a};
        hipError_t e = hipLaunchCooperativeKernel((const void*)fwd_kernel, dim3(grid), dim3(512), kargs, LDS_BYTES, stream);
        if (e != hipSuccess) { fprintf(stderr, "launch %d failed: %s\n", ph, hipGetErrorString(e)); break; } }
#endif
}
```

```cpp
#include <hip/hip_runtime.h>
#include <hip/hip_cooperative_groups.h>
#include <cstdio>
#include <cstdint>
namespace cg = cooperative_groups;
__device__ __forceinline__ float opaque_zero() { float z; asm volatile("v_mov_b32 %0, 0" : "=v"(z)); return z; }
namespace pg8 {
#define PG8_LAS __attribute__((address_space(3)))
typedef unsigned short bf16_t;
typedef short bf16x8 __attribute__((ext_vector_type(8)));
typedef float f32x4 __attribute__((ext_vector_type(4)));
typedef unsigned u32x4 __attribute__((ext_vector_type(4)));
constexpr int BM = 256, BK = 64, HALF = 128, HTB = HALF * BK * 2  , STAGE_BYTES = 8 * HTB, NXCD = 8, WGM = 8;

__host__ __device__ __forceinline__ int lds_byte(int r, int c) { const int st = (r >> 4) * 2 + (c >> 5), rr = r & 15, cc = c & 31, ob = rr * 64 + cc * 2; return st * 1024 + (ob ^ (((ob >> 9) & 1) << 5)); }
__host__ __device__ __forceinline__ void stage_rc(int b, int& R, int& C) { const int st = b / 1024, sb = b % 1024, swz = sb ^ (((sb >> 9) & 1) << 5); R = (st >> 1) * 16 + swz / 64; C = (st & 1) * 32 + (swz % 64) / 2; }
__host__ __device__ __forceinline__ int perm32(int rho) { const int n = rho >> 4, i = rho & 15; return 8 * (i >> 2) + 4 * n + (i & 3); }

struct Unit { int pm, pn, k0, nt, split; };
struct Gemm { const bf16_t* A; const bf16_t* Bt; int M, N, K; };

struct StaticOrder {
    int nM, nN, nwg, G, c, ntk, nfull, L, P;
    __host__ __device__ void init(int M, int N, int G_, int c_, int ntk_, bool split) {
        nM = M / BM; nN = N / BM; G = G_; c = c_; ntk = ntk_; L = 0; P = 1;
        if (split && nM == 136 && (128 * nN) % G == 0 && G % (8 * nN) == 0 && G / (8 * nN) <= ntk / 2) { nM = 128; L = 8 * nN; P = G / L; }
        nwg = nM * nN; nfull = nwg;
    }
    __host__ __device__ void map(int wgid, Unit& u) const {
        { const int q = nwg / NXCD, r = nwg % NXCD, xcd = wgid % NXCD, off = wgid / NXCD; wgid = (xcd < r ? xcd * (q + 1) : r * (q + 1) + (xcd - r) * q) + off; }
        const int nig = WGM * nN, gid = wgid / nig, fm = gid * WGM, gsz = (nM - fm) < WGM ? (nM - fm) : WGM;
        u.pm = fm + ((wgid % nig) % gsz); u.pn = (wgid % nig) / gsz;
    }
    __host__ __device__ bool next(int i, Unit& u) const {
        if (L > 0 && (c & 1)) { if (i == 0) { if (c >= L * P) return false; goto piece; } --i; if ((long)i * G + c >= nfull) return false; }
        { const long Lid = (long)i * G + c;
          if (Lid < nfull) { map((int)Lid, u); u.k0 = 0; u.nt = ntk; u.split = 0; return true; } }
        if (L == 0 || i != nfull / G || c >= L * P) return false;
        piece:
        const int j = c / P, piece = c % P, pairs = ntk / 2, base = pairs / P, rem = pairs % P;
        u.pm = 128 + j / nN; u.pn = j % nN;
        u.k0 = 2 * (piece * base + (piece < rem ? piece : rem)); u.nt = 2 * (base + (piece < rem ? 1 : 0)); u.split = piece + 1; return true;
    }
    __device__ __forceinline__ void a_ready(const Unit&) const {}
    __device__ __forceinline__ void done(const Unit&) const {}
};

template <class Epi, class Sched, bool ALIGN_EPI = false, bool SP2 = false>
__device__ __forceinline__ void gemm_phase(PG8_LAS unsigned char* lds, const Gemm g, const Sched& S, const Epi& E) {
    int tid_ = threadIdx.x; asm volatile("" : "+v"(tid_));
    const int tid = tid_, wid = __builtin_amdgcn_readfirstlane(tid >> 6), lane = tid & 63, wr = wid >> 2, wc = wid & 3, fr = lane & 15, fq = lane >> 4;
    const int K = g.K, nt = K / BK;
    unsigned voffA[2], voffB[2];
#pragma unroll
    for (int i = 0; i < 2; ++i) { int R, C; stage_rc(tid * 16 + i * 8192, R, C); const int Rb = Epi::PERM ? ((R & ~31) + perm32(R & 31)) : R;
        voffA[i] = (unsigned)(R * K + C) * 2u; voffB[i] = (unsigned)(Rb * K + C) * 2u; }
    const size_t kstep = (size_t)(BK * 2);
    const size_t hstep = (size_t)HALF * K * 2;
    const size_t tstep = 2 * hstep;
    const unsigned ldsw = (unsigned)wid * 1024u;
    const int aoff = lds_byte(wr * 64 + fr, fq * 8), boff = lds_byte(wc * 32 + fr, fq * 8);
#define PG8_SA(b, h) (((b) * 2 + (h)) * HTB)
#define PG8_SB(b, h) ((4 + (b) * 2 + (h)) * HTB)
#define PG8_STAGE(bufoff, gbase, voff) do { _Pragma("unroll") for (int _i = 0; _i < 2; ++_i) \
        __builtin_amdgcn_global_load_lds((const unsigned*)((const char*)(gbase) + (voff)[_i]), (PG8_LAS unsigned*)(lds + (bufoff) + ldsw + _i * 8192), 16, 0, 0); } while (0)
#define PG8_LDA(dst, b, h) do { _Pragma("unroll") for (int m = 0; m < 4; ++m) _Pragma("unroll") for (int k = 0; k < 2; ++k) dst[m][k] = *(const PG8_LAS bf16x8*)(lds + PG8_SA(b, h) + aoff + m * 2048 + k * 1024); } while (0)
#define PG8_LDB(dst, b, h) do { _Pragma("unroll") for (int n = 0; n < 2; ++n) _Pragma("unroll") for (int k = 0; k < 2; ++k) dst[n][k] = *(const PG8_LAS bf16x8*)(lds + PG8_SB(b, h) + boff + n * 2048 + k * 1024); } while (0)
#define PG8_MMA(ai, bj, At, Bt) do { __builtin_amdgcn_s_setprio(1); _Pragma("unroll") for (int m = 0; m < 4; ++m) _Pragma("unroll") for (int n = 0; n < 2; ++n) _Pragma("unroll") for (int k = 0; k < 2; ++k) \
        acc[ai][bj][m][n] = __builtin_amdgcn_mfma_f32_16x16x32_bf16(Bt[n][k], At[m][k], acc[ai][bj][m][n], 0, 0, 0); __builtin_amdgcn_s_setprio(0); } while (0)
#define PG8_WAIT_V(n) asm volatile("s_waitcnt vmcnt(" #n ")" ::: "memory")
#define PG8_WAIT_L(n) asm volatile("s_waitcnt lgkmcnt(" #n ")" ::: "memory")
#define PG8_BAR __builtin_amdgcn_s_barrier()
#define PG8_SCHED __builtin_amdgcn_sched_barrier(0)
    Unit cur, nxt; int ui = 0;
    if (!S.next(0, cur)) return;
    f32x4 acc[2][2][4][2];
#pragma unroll
    for (int a = 0; a < 2; ++a)
#pragma unroll
        for (int b = 0; b < 2; ++b)
#pragma unroll
            for (int m = 0; m < 4; ++m)
#pragma unroll
                for (int n = 0; n < 2; ++n) { const float z0_ = opaque_zero(); acc[a][b][m][n] = (f32x4){z0_, z0_, z0_, z0_}; }
    bf16x8 At[4][2], B0[2][2], B1[2][2];
    const char* cA = (const char*)g.A + (size_t)cur.pm * tstep + (size_t)cur.k0 * kstep; const char* cB = (const char*)g.Bt + (size_t)cur.pn * tstep + (size_t)cur.k0 * kstep;
    S.a_ready(cur);
    if constexpr (SP2) {
        PG8_STAGE(PG8_SB(0, 0), cB, voffB); PG8_STAGE(PG8_SB(0, 1), cB + hstep, voffB); PG8_STAGE(PG8_SA(0, 0), cA, voffA); PG8_STAGE(PG8_SA(0, 1), cA + hstep, voffA);
        if (wr == 1) PG8_BAR;
        PG8_WAIT_V(2); PG8_BAR;
        PG8_STAGE(PG8_SB(1, 0), cB + kstep, voffB); PG8_STAGE(PG8_SA(1, 0), cA + kstep, voffA); PG8_STAGE(PG8_SB(1, 1), cB + hstep + kstep, voffB);
        PG8_WAIT_V(6); PG8_BAR;
    } else {
        PG8_STAGE(PG8_SB(0, 0), cB, voffB); PG8_STAGE(PG8_SA(0, 0), cA, voffA); PG8_STAGE(PG8_SB(0, 1), cB + hstep, voffB); PG8_STAGE(PG8_SA(0, 1), cA + hstep, voffA);
        if (wr == 1) PG8_BAR;
        PG8_WAIT_V(4); PG8_BAR;
        PG8_STAGE(PG8_SB(1, 0), cB + kstep, voffB); PG8_STAGE(PG8_SA(1, 0), cA + kstep, voffA); PG8_STAGE(PG8_SB(1, 1), cB + hstep + kstep, voffB);
        PG8_WAIT_V(6); PG8_BAR;
    }
    for (;;) {
        const bool has_next = S.next(ui + 1, nxt);
        const char* nA = has_next ? (const char*)g.A + (size_t)nxt.pm * tstep + (size_t)nxt.k0 * kstep : cA; const char* nB = has_next ? (const char*)g.Bt + (size_t)nxt.pn * tstep + (size_t)nxt.k0 * kstep : cB;
        const int nt_u = cur.nt;
        for (int t = 0; t < nt_u; t += 2) {
            const bool last = (t == nt_u - 2);
            const char* a1 = cA + (size_t)(t + 1) * kstep;
            const char* a2 = last ? nA : cA + (size_t)(t + 2) * kstep; const char* b2 = last ? nB : cB + (size_t)(t + 2) * kstep;
            const char* a3 = a2 + kstep; const char* b3 = b2 + kstep;
            if (last && has_next) S.a_ready(nxt);
            if constexpr (SP2) {
            PG8_LDB(B0, 0, 0); PG8_LDB(B1, 0, 1); PG8_SCHED; PG8_LDA(At, 0, 0); PG8_STAGE(PG8_SA(1, 1), a1 + hstep, voffA);
            PG8_WAIT_V(8); PG8_WAIT_L(0); PG8_BAR; PG8_MMA(0, 0, At, B0); PG8_MMA(0, 1, At, B1); PG8_BAR; PG8_SCHED;
            PG8_LDA(At, 0, 1); PG8_STAGE(PG8_SB(0, 0), b2, voffB); PG8_STAGE(PG8_SB(0, 1), b2 + hstep, voffB); PG8_STAGE(PG8_SA(0, 0), a2, voffA);
            PG8_WAIT_V(8); PG8_WAIT_L(0); PG8_BAR; PG8_MMA(1, 0, At, B0); PG8_MMA(1, 1, At, B1); PG8_BAR; PG8_SCHED;
            PG8_LDB(B0, 1, 0); PG8_LDB(B1, 1, 1); PG8_SCHED; PG8_LDA(At, 1, 0); PG8_STAGE(PG8_SA(0, 1), a2 + hstep, voffA);
            PG8_WAIT_V(8); PG8_WAIT_L(0); PG8_BAR; PG8_MMA(0, 0, At, B0); PG8_MMA(0, 1, At, B1); PG8_BAR; PG8_SCHED;
            PG8_LDA(At, 1, 1); PG8_STAGE(PG8_SB(1, 0), b3, voffB); PG8_STAGE(PG8_SB(1, 1), b3 + hstep, voffB); PG8_STAGE(PG8_SA(1, 0), a3, voffA);
            PG8_WAIT_V(8); PG8_WAIT_L(0); PG8_BAR; PG8_MMA(1, 0, At, B0); PG8_MMA(1, 1, At, B1); PG8_BAR; PG8_SCHED;
            } else {
            PG8_LDB(B0, 0, 0); PG8_SCHED; PG8_LDA(At, 0, 0); PG8_STAGE(PG8_SA(1, 1), a1 + hstep, voffA);
            PG8_WAIT_L(8); PG8_BAR; PG8_WAIT_L(0); PG8_MMA(0, 0, At, B0); PG8_BAR; PG8_SCHED;
            PG8_LDB(B1, 0, 1); PG8_STAGE(PG8_SB(0, 0), b2, voffB);
            PG8_BAR; PG8_WAIT_L(0); PG8_MMA(0, 1, At, B1); PG8_BAR;
            PG8_LDA(At, 0, 1); PG8_STAGE(PG8_SA(0, 0), a2, voffA);
            PG8_BAR; PG8_WAIT_L(0); PG8_MMA(1, 0, At, B0); PG8_BAR; PG8_SCHED;
            PG8_STAGE(PG8_SB(0, 1), b2 + hstep, voffB);
            PG8_WAIT_V(6); PG8_BAR; PG8_MMA(1, 1, At, B1); PG8_BAR;
            PG8_LDB(B0, 1, 0); PG8_SCHED; PG8_LDA(At, 1, 0); PG8_STAGE(PG8_SA(0, 1), a2 + hstep, voffA);
            PG8_WAIT_L(8); PG8_BAR; PG8_WAIT_L(0); PG8_MMA(0, 0, At, B0); PG8_BAR; PG8_SCHED;
            PG8_LDB(B1, 1, 1); PG8_STAGE(PG8_SB(1, 0), b3, voffB);
            PG8_BAR; PG8_WAIT_L(0); PG8_MMA(0, 1, At, B1); PG8_BAR;
            PG8_LDA(At, 1, 1); PG8_STAGE(PG8_SA(1, 0), a3, voffA);
            PG8_BAR; PG8_WAIT_L(0); PG8_MMA(1, 0, At, B0); PG8_BAR; PG8_SCHED;
            PG8_STAGE(PG8_SB(1, 1), b3 + hstep, voffB);
            PG8_WAIT_V(6); PG8_BAR; PG8_MMA(1, 1, At, B1); PG8_BAR;
            }
        }
        if constexpr (ALIGN_EPI) { if (wr == 0) PG8_BAR; }
        if constexpr (!Epi::AFTER_DRAIN) { E(acc, cur, wr, wc, fr, fq); S.done(cur); }
        if (!has_next) break;
#pragma unroll
        for (int a = 0; a < 2; ++a)
#pragma unroll
            for (int b = 0; b < 2; ++b)
#pragma unroll
                for (int m = 0; m < 4; ++m)
#pragma unroll
                    for (int n = 0; n < 2; ++n) { const float z0_ = opaque_zero(); acc[a][b][m][n] = (f32x4){z0_, z0_, z0_, z0_}; }
        cur = nxt; cA = nA; cB = nB; ++ui;
        if constexpr (ALIGN_EPI) { if (wr == 1) PG8_BAR; }
    }
    PG8_WAIT_V(0);
    if constexpr (!ALIGN_EPI) { if (wr == 0) PG8_BAR; }
    PG8_BAR;
    if constexpr (Epi::AFTER_DRAIN) { E.fused(acc, cur, wr, wc, fr, fq, lds, wid, lane); S.done(cur); }
#undef PG8_SA
#undef PG8_SB
#undef PG8_STAGE
#undef PG8_LDA
#undef PG8_LDB
#undef PG8_MMA
#undef PG8_WAIT_V
#undef PG8_WAIT_L
#undef PG8_BAR
#undef PG8_SCHED
}
}

#define LAS __attribute__((address_space(3)))
#define GAS __attribute__((address_space(1)))
typedef unsigned short bf16_t;
typedef short bf16x8 __attribute__((ext_vector_type(8)));
typedef float f32x4 __attribute__((ext_vector_type(4)));
typedef float f32x2 __attribute__((ext_vector_type(2)));
typedef float f32x16 __attribute__((ext_vector_type(16)));
typedef unsigned u32x4 __attribute__((ext_vector_type(4)));
typedef unsigned u32x2 __attribute__((ext_vector_type(2)));
typedef const GAS float* gcf;
typedef GAS float* gf;
typedef const GAS bf16_t* gcb;
typedef GAS bf16_t* gb;

constexpr int DM = 1024, SEQ = 4096, NB = 8, CTXL = 256, DFF = 2816;
constexpr int MLAT = NB * SEQ;
constexpr int MTOT = MLAT + NB * CTXL;
constexpr int NMODC = 9 * DM;
constexpr float EPS = 1e-6f;
constexpr float LOG2E = 1.4426950408889634f;
constexpr float LAM_INIT = 0.35550906759096934f;

constexpr size_t MiB = 1u << 20;
constexpr size_t WS_MODS = 0, WS_TAB = 2 * MiB, WS_BAR = 3 * MiB, BAR_ZERO_BYTES = 16384, WS_W0 = 4 * MiB, WS_WSZ = 44 * MiB, WS_X = 92 * MiB, WS_HN = 228 * MiB, WS_S = 296 * MiB, WS_END = 636 * MiB;
constexpr size_t S_HH = 0, S_PART = 192 * MiB;
constexpr size_t S_A = 0, S_CQN = 102 * MiB, S_CKVN = 128 * MiB, S_KR = 146 * MiB, S_Q = 152 * MiB, S_KN = 0, S_VT_MLA = 256 * MiB;
constexpr size_t S_QK = 0, S_VT_DIFF = 136 * MiB, S_O2 = 204 * MiB, S_VT_SWA = 88 * MiB;
constexpr size_t OFF_WIN0 = 0, OFF_WOUT0 = 5767168, OFF_WIN1 = 8650752, OFF_WOUT1 = 14417920, OFF_MIX = 17301504;
constexpr size_t MLA_WA = 0, MLA_WQB = 786432, MLA_WKN = 1376256, MLA_WVT = 1638400, MLA_WO = 1900544;
constexpr size_t DIF_WQK = 0, DIF_WV = 2097152, DIF_WO = 3145728;
constexpr size_t SWA_WQK = 0, SWA_WV = 1310720, SWA_WO = 1572864;

constexpr int LDS_BYTES = 147456;

__device__ const float INVF[16] = {1.0f, 0.5623413324356079f, 0.3162277638912201f, 0.17782793939113617f, 0.10000000149011612f, 0.05623413249850273f, 0.03162277489900589f, 0.017782794311642647f,
                                   0.009999999776482582f, 0.005623413249850273f, 0.003162277629598975f, 0.0017782794311642647f, 0.0010000000474974513f, 0.000562341301701963f, 0.0003162277571391314f, 0.00017782794020604342f};

enum { OP_PRO = 0, OP_NORM, OP_FFN_IN, OP_FFN_OUT, OP_MLA_IN, OP_MLA_ROW, OP_PROJ, OP_ATT, OP_DIFF_ROW, OP_MIX_OUT, OP_FINAL };
#ifndef DUP_MASK
#define DUP_MASK 0
#endif
#ifndef DUP_SYNC
#define DUP_SYNC 0
#endif
#ifndef PROBE_SKIP_EPI
#define PROBE_SKIP_EPI 0
#endif
struct Prog { unsigned e[128]; int n; };
constexpr void prog_add(Prog& p, int op, int l, int s) {
    p.e[p.n++] = (unsigned)op | ((unsigned)l << 8) | ((unsigned)s << 16);
    if ((DUP_MASK >> op) & 1) p.e[p.n++] = (unsigned)op | ((unsigned)l << 8) | ((unsigned)(s | 0x80) << 16);
}
constexpr Prog make_prog() {
    Prog p{}; p.n = 0;
    prog_add(p, OP_PRO, 0, 0);
    for (int l = 0; l < 4; ++l) {
        const int kind = l % 3;
        prog_add(p, OP_NORM, l, 0); prog_add(p, OP_FFN_IN, l, 0); prog_add(p, OP_FFN_OUT, l, 0); prog_add(p, OP_NORM, l, 1);
        if (kind == 0) { prog_add(p, OP_MLA_IN, l, 0); prog_add(p, OP_MLA_ROW, l, 0); }
        prog_add(p, OP_PROJ, l, 0); prog_add(p, OP_ATT, l, 0);
        if (kind == 1) prog_add(p, OP_DIFF_ROW, l, 0);
        prog_add(p, OP_MIX_OUT, l, 0); prog_add(p, OP_NORM, l, 2); prog_add(p, OP_FFN_IN, l, 1); prog_add(p, OP_FFN_OUT, l, 1);
    }
    prog_add(p, OP_FINAL, 0, 0);
    return p;
}
constexpr Prog PROG_H = make_prog();
constexpr int NPHASE = PROG_H.n;
__device__ const Prog PROG_D = make_prog();

__device__ __forceinline__ unsigned pk2(float lo, float hi) { typedef __bf16 bf16x2_t __attribute__((ext_vector_type(2))); f32x2 v = {lo, hi}; bf16x2_t b = __builtin_convertvector(v, bf16x2_t); return __builtin_bit_cast(unsigned, b); }
__device__ __forceinline__ float wave_sum_l(float v, int lane) {
#pragma unroll
    for (int o = 1; o < 64; o <<= 1) v += __int_as_float(__builtin_amdgcn_ds_bpermute((lane ^ o) << 2, __float_as_int(v)));
    return v;
}
#define wave_sum(v) wave_sum_l((v), lane)
__device__ __forceinline__ float fast_exp2(float x) { return __builtin_amdgcn_exp2f(x); }
__device__ __forceinline__ float silu_fast(float x) { return x * __builtin_amdgcn_rcpf(1.0f + __builtin_amdgcn_exp2f(-x * LOG2E)); }
__device__ __forceinline__ float half_max(float m) { auto rr = __builtin_amdgcn_permlane32_swap(__float_as_uint(m), __float_as_uint(m), false, false); return fmaxf(__uint_as_float(rr[0]), __uint_as_float(rr[1])); }
__device__ __forceinline__ float half_sum(float m) { auto rr = __builtin_amdgcn_permlane32_swap(__float_as_uint(m), __float_as_uint(m), false, false); return __uint_as_float(rr[0]) + __uint_as_float(rr[1]); }

struct EpiStoreBf16 {
    static constexpr bool PERM = true, AFTER_DRAIN = false;
    gb O; int ldc;
    __device__ __forceinline__ void operator()(const f32x4 (&acc)[2][2][4][2], const pg8::Unit& u, int wr, int wc, int fr, int fq) const {
        const int row0 = u.pm * 256 + wr * 64 + fr, col0 = u.pn * 256 + wc * 32 + 8 * fq;
#pragma unroll
        for (int ai = 0; ai < 2; ++ai)
#pragma unroll
            for (int m = 0; m < 4; ++m) { gb rowp = O + (size_t)(row0 + ai * 128 + m * 16) * ldc + col0;
#pragma unroll
                for (int bj = 0; bj < 2; ++bj) { const f32x4 v0 = acc[ai][bj][m][0], v1 = acc[ai][bj][m][1];
                    u32x4 w; w.x = pk2(v0[0], v0[1]); w.y = pk2(v0[2], v0[3]); w.z = pk2(v1[0], v1[1]); w.w = pk2(v1[2], v1[3]);
                    *(GAS u32x4*)(rowp + bj * 128) = w; } }
    }
};
struct EpiSwiglu {
    static constexpr bool PERM = true, AFTER_DRAIN = false;
    gb O;
    __device__ __forceinline__ void operator()(const f32x4 (&acc)[2][2][4][2], const pg8::Unit& u, int wr, int wc, int fr, int fq) const {
        const int row0 = u.pm * 256 + wr * 64 + fr, col0 = u.pn * 128 + wc * 32 + 8 * fq;
#pragma unroll
        for (int ai = 0; ai < 2; ++ai)
#pragma unroll
            for (int m = 0; m < 4; ++m) { gb rowp = O + (size_t)(row0 + ai * 128 + m * 16) * DFF + col0;
                const f32x4 g0 = acc[ai][0][m][0], g1 = acc[ai][0][m][1], u0 = acc[ai][1][m][0], u1 = acc[ai][1][m][1];
                u32x4 w; w.x = pk2(silu_fast(g0[0]) * u0[0], silu_fast(g0[1]) * u0[1]); w.y = pk2(silu_fast(g0[2]) * u0[2], silu_fast(g0[3]) * u0[3]);
                w.z = pk2(silu_fast(g1[0]) * u1[0], silu_fast(g1[1]) * u1[1]); w.w = pk2(silu_fast(g1[2]) * u1[2], silu_fast(g1[3]) * u1[3]);
                *(GAS u32x4*)rowp = w; }
    }
};
struct EpiResid {
    static constexpr bool PERM = true, AFTER_DRAIN = false;
    gcf base_lat, base_ctx; gf X; gcf gate; unsigned gsc_bits;
    __device__ __forceinline__ void operator()(const f32x4 (&acc)[2][2][4][2], const pg8::Unit& u, int wr, int wc, int fr, int fq) const {
        if (PROBE_SKIP_EPI && gsc_bits == 0u) return;
        const int b = u.pm < 128 ? (u.pm >> 4) : 8;
        const int col0 = u.pn * 256 + wc * 32 + 8 * fq;
        gcf gp = gate + (size_t)b * NMODC + col0;
        f32x4 gv[2][2];
#pragma unroll
        for (int bj = 0; bj < 2; ++bj)
#pragma unroll
            for (int n = 0; n < 2; ++n) gv[bj][n] = *(const GAS f32x4*)(gp + bj * 128 + n * 4) * __uint_as_float(gsc_bits);
#pragma unroll
        for (int ai = 0; ai < 2; ++ai)
#pragma unroll
            for (int m = 0; m < 4; ++m) { const int row = u.pm * 256 + ai * 128 + wr * 64 + m * 16 + fr;
                gcf bp = (row < MLAT ? base_lat + (size_t)row * DM : base_ctx + (size_t)(row - MLAT) * DM) + col0;
                gf xp = X + (size_t)row * DM + col0;
#pragma unroll
                for (int bj = 0; bj < 2; ++bj)
#pragma unroll
                    for (int n = 0; n < 2; ++n) {
                        if (u.split) { gf part = (gf)((GAS unsigned char*)X + (WS_S + S_PART - WS_X)); *(GAS f32x4*)(part + ((size_t)(u.split - 1) * 2048 + (row - MLAT)) * DM + col0 + bj * 128 + n * 4) = acc[ai][bj][m][n]; }
                        else { const f32x4 bs = *(const GAS f32x4*)(bp + bj * 128 + n * 4); *(GAS f32x4*)(xp + bj * 128 + n * 4) = bs + gv[bj][n] * acc[ai][bj][m][n]; } } }
    }
};
struct EpiF32 {
    static constexpr bool PERM = false, AFTER_DRAIN = false;
    gf O; int ldc;
    __device__ __forceinline__ void operator()(const f32x4 (&acc)[2][2][4][2], const pg8::Unit& u, int wr, int wc, int fr, int fq) const {
        const int col0 = u.pn * 256 + wc * 32 + 4 * fq;
#pragma unroll
        for (int ai = 0; ai < 2; ++ai)
#pragma unroll
            for (int m = 0; m < 4; ++m) { gf op = O + (size_t)(u.pm * 256 + ai * 128 + wr * 64 + m * 16 + fr) * ldc + col0;
#pragma unroll
                for (int bj = 0; bj < 2; ++bj)
#pragma unroll
                    for (int n = 0; n < 2; ++n) *(GAS f32x4*)(op + bj * 128 + n * 16) = acc[ai][bj][m][n]; }
    }
};
struct EpiRope {
    static constexpr bool PERM = false, AFTER_DRAIN = false;
    gb O; int ldc, period, rope_start, nq; float qscale; gcf tab;
    __device__ __forceinline__ void operator()(const f32x4 (&acc)[2][2][4][2], const pg8::Unit& u, int wr, int wc, int fr, int fq) const {
        const bool lat = u.pm < 128;
#pragma unroll
        for (int bj = 0; bj < 2; ++bj) {
            const int colg = u.pn * 256 + bj * 128 + wc * 32, cm = colg % period;
            const bool rope = lat && (cm >= rope_start);
            const int axis = ((cm - rope_start) >> 5) & 1;
            const float sc = colg < nq ? qscale : 1.0f;
#pragma unroll
            for (int ai = 0; ai < 2; ++ai)
#pragma unroll
                for (int m = 0; m < 4; ++m) { const int row = u.pm * 256 + ai * 128 + wr * 64 + m * 16 + fr;
                    f32x4 x1 = acc[ai][bj][m][0], x2 = acc[ai][bj][m][1];
                    if (rope) { const int t = row & (SEQ - 1), pos = axis ? (t & 63) : (t >> 6);
                        const GAS f32x4* tp = (const GAS f32x4*)(tab + (pos * 16 + 4 * fq) * 2);
                        const f32x4 t0 = tp[0], t1 = tp[1];
                        const f32x4 c = {t0[0], t0[2], t1[0], t1[2]}, s = {t0[1], t0[3], t1[1], t1[3]};
                        const f32x4 o1 = x1 * c - x2 * s, o2 = x2 * c + x1 * s; x1 = o1; x2 = o2; }
                    x1 = x1 * sc; x2 = x2 * sc;
                    gb op = O + (size_t)row * ldc + colg + 4 * fq;
                    u32x2 w1, w2; w1.x = pk2(x1[0], x1[1]); w1.y = pk2(x1[2], x1[3]); w2.x = pk2(x2[0], x2[1]); w2.y = pk2(x2[2], x2[3]);
                    *(GAS u32x2*)op = w1; *(GAS u32x2*)(op + 16) = w2;
                    asm volatile("" ::: "memory"); }
        }
    }
};

template <class Epi> __device__ __forceinline__ void run_gemm(LAS unsigned char* lds, int G_, int bx_, gcb A, gcb Bt, int M, int N, int K, const Epi& E, bool split = false) {
    pg8::Gemm g{(const bf16_t*)A, (const bf16_t*)Bt, M, N, K}; pg8::StaticOrder S; S.init(M, N, G_, bx_, K / 64, split);
    pg8::gemm_phase<Epi, pg8::StaticOrder, true, true>(lds, g, S, E);
}

__device__ __forceinline__ unsigned f2bf(float f) { unsigned u = __builtin_bit_cast(unsigned, f); return (u + 0x7fffu + ((u >> 16) & 1u)) >> 16; }
__device__ __forceinline__ unsigned pk2s(float lo, float hi) { return f2bf(lo) | (f2bf(hi) << 16); }
__device__ __forceinline__ void conv_item(gcf W, int K, int N, int k0, int n0, gb drow, LAS float* scr, int lane) {
#pragma unroll 8
    for (int i = 0; i < 32; ++i) { const int kk = 2 * i + (lane >> 5); scr[kk * 33 + (lane & 31)] = W[(size_t)(k0 + kk) * N + n0 + (lane & 31)]; }
    asm volatile("s_waitcnt lgkmcnt(0)" ::: "memory");
    const int c = lane & 7;
#pragma unroll
    for (int j = 0; j < 4; ++j) { const int n = (lane >> 3) + 8 * j; const LAS float* s = scr + (8 * c) * 33 + n;
        u32x4 o; o.x = pk2s(s[0 * 33], s[1 * 33]); o.y = pk2s(s[2 * 33], s[3 * 33]); o.z = pk2s(s[4 * 33], s[5 * 33]); o.w = pk2s(s[6 * 33], s[7 * 33]);
        *(GAS u32x4*)(drow + (size_t)n * K + k0 + 8 * c) = o; }
    asm volatile("s_waitcnt lgkmcnt(0)" ::: "memory");
}
__device__ __forceinline__ bool conv_job(int& r, gcf W, int K, int N, int kind, gb d1, gb d2, int S, LAS float* scr, int lane) {
    const int nblk = N / 32, items = (K / 64) * nblk;
    if (r >= items) { r -= items; return false; }
    const int kb = r / nblk, nb = r % nblk, k0 = 64 * kb, n0 = 32 * nb;
    gb drow;
    if (kind == 0) drow = d1 + (size_t)n0 * K;
    else if (kind == 1) { const int nn = n0 < DFF ? n0 : n0 - DFF; drow = d1 + (size_t)(256 * (nn / 128) + (n0 < DFF ? 0 : 128) + (nn % 128)) * K; }
    else if (kind == 2) drow = n0 < S ? d1 + (size_t)n0 * K : d2 + (size_t)(n0 - S) * K;
    else { const int h = n0 / 256, off = n0 % 256; drow = off < 128 ? d1 + (size_t)(h * 128 + off) * K : d2 + (size_t)(h * 128 + off - 128) * K; }
    conv_item(W, K, N, k0, n0, drow, scr, lane);
    return true;
}

struct Ptrs {
    gcf x, c, ctx, c_ctx, w_mod, b_mod, g_norm, w_ffn_in, w_ffn_out, a_w_in, a_g_q, a_g_kv, a_w_qb, a_w_kvb, a_w_o, b_w_qkv, b_lambda, b_g_sub, b_w_o, c_w_qkv, c_sink, c_w_o, g_final;
    gf out; GAS unsigned char* ws; int bx, G;
};

__device__ __forceinline__ void conv_layer(const Ptrs& P, int l, LAS unsigned char* lds, int tid, int wid, int lane) {
    gb Wd = (gb)(P.ws + WS_W0 + (size_t)(l & 1) * WS_WSZ);
    LAS float* scr = (LAS float*)(lds + wid * 16384);
    const int gw = P.bx * 8 + wid, NGW = P.G * 8;
    const int kind = l % 3, j = l / 3;
    gcf fin0 = P.w_ffn_in + (size_t)(l * 2 + 0) * DM * 2 * DFF, fin1 = P.w_ffn_in + (size_t)(l * 2 + 1) * DM * 2 * DFF;
    gcf fo0 = P.w_ffn_out + (size_t)(l * 2 + 0) * DFF * DM, fo1 = P.w_ffn_out + (size_t)(l * 2 + 1) * DFF * DM;
    gb mix = Wd + OFF_MIX;
    for (int it = gw; it < 16384; it += NGW) {
        int r = it;
        if (conv_job(r, fin0, DM, 2 * DFF, 1, Wd + OFF_WIN0, Wd, 0, scr, lane)) continue;
        if (conv_job(r, fo0, DFF, DM, 0, Wd + OFF_WOUT0, Wd, 0, scr, lane)) continue;
        if (conv_job(r, fin1, DM, 2 * DFF, 1, Wd + OFF_WIN1, Wd, 0, scr, lane)) continue;
        if (conv_job(r, fo1, DFF, DM, 0, Wd + OFF_WOUT1, Wd, 0, scr, lane)) continue;
        if (kind == 0) {
            if (conv_job(r, P.a_w_in + (size_t)j * DM * 704, DM, 704, 0, mix + MLA_WA, mix, 0, scr, lane)) continue;
            if (conv_job(r, P.a_w_qb + (size_t)j * 384 * 1536, 384, 1536, 0, mix + MLA_WQB, mix, 0, scr, lane)) continue;
            if (conv_job(r, P.a_w_kvb + (size_t)j * 256 * 2048, 256, 2048, 3, mix + MLA_WKN, mix + MLA_WVT, 0, scr, lane)) continue;
            if (conv_job(r, P.a_w_o + (size_t)j * DM * DM, DM, DM, 0, mix + MLA_WO, mix, 0, scr, lane)) continue;
        } else if (kind == 1) {
            if (conv_job(r, P.b_w_qkv, DM, 3072, 2, mix + DIF_WQK, mix + DIF_WV, 2048, scr, lane)) continue;
            if (conv_job(r, P.b_w_o, DM, DM, 0, mix + DIF_WO, mix, 0, scr, lane)) continue;
        } else {
            if (conv_job(r, P.c_w_qkv, DM, 1536, 2, mix + SWA_WQK, mix + SWA_WV, 1280, scr, lane)) continue;
            if (conv_job(r, P.c_w_o, DM, DM, 0, mix + SWA_WO, mix, 0, scr, lane)) continue;
        }
        break;
    }
    if (kind == 0) {
        const int gt = P.bx * 512 + tid, NT = P.G * 512;
        for (int i = gt; i < 8192; i += NT) { const unsigned zz = __float_as_uint(opaque_zero()); *(GAS u32x4*)(mix + MLA_WA + (size_t)704 * DM + (size_t)i * 8) = (u32x4){zz, zz, zz, zz}; }
    }
}

__device__ __forceinline__ void sincos_d(double a, float& c, float& s) {
    const double TWO_PI = 6.283185307179586476925286766559;
    const double k = __builtin_rint(a / TWO_PI); const double r = a - k * TWO_PI, r2 = r * r;
    double ts = r, ss = r, tc = 1.0, cc = 1.0;
#pragma unroll
    for (int i = 1; i <= 14; ++i) { tc *= -r2 / (double)((2 * i - 1) * (2 * i)); cc += tc; ts *= -r2 / (double)((2 * i) * (2 * i + 1)); ss += ts; }
    c = (float)cc; s = (float)ss;
}
__device__ __forceinline__ void prologue(const Ptrs& P, LAS unsigned char* lds, int tid, int wid, int lane) {
    if (P.bx == 0) {
        gf tab = (gf)(P.ws + WS_TAB);
        for (int idx = tid; idx < 1024; idx += 512) { const int pos = idx >> 4, i = idx & 15; const float ang = (float)pos * INVF[i]; float c, s; sincos_d((double)ang, c, s); tab[idx * 2] = c; tab[idx * 2 + 1] = s; }
    }
    LAS float* sS = (LAS float*)lds;
    LAS float* red = (LAS float*)(lds + 49152);
    for (int idx = tid; idx < 9 * DM; idx += 512) { const int b = idx >> 10, k = idx & 1023; const float v = b < 8 ? P.c[b * DM + k] : P.c_ctx[k]; sS[k * 12 + b] = v / (1.0f + __expf(-v)); }
    __syncthreads();
    gf mods = (gf)(P.ws + WS_MODS);
    for (int u = P.bx; u < 4 * 72; u += P.G) {
        const int l = u / 72, n0 = (u % 72) * 128;
        gcf wp = P.w_mod + ((size_t)l * DM + wid * 128) * NMODC + n0 + 2 * lane;
        float acc[9][2];
#pragma unroll
        for (int b = 0; b < 9; ++b) { acc[b][0] = 0.f; acc[b][1] = 0.f; }
#pragma unroll 8
        for (int k = 0; k < 128; ++k) {
            const f32x2 w = *(const GAS f32x2*)(wp + (size_t)k * NMODC);
            const LAS f32x4* sp = (const LAS f32x4*)(sS + (wid * 128 + k) * 12);
            const f32x4 s0 = sp[0], s1 = sp[1], s2 = sp[2];
            acc[0][0] += s0[0] * w[0]; acc[0][1] += s0[0] * w[1]; acc[1][0] += s0[1] * w[0]; acc[1][1] += s0[1] * w[1];
            acc[2][0] += s0[2] * w[0]; acc[2][1] += s0[2] * w[1]; acc[3][0] += s0[3] * w[0]; acc[3][1] += s0[3] * w[1];
            acc[4][0] += s1[0] * w[0]; acc[4][1] += s1[0] * w[1]; acc[5][0] += s1[1] * w[0]; acc[5][1] += s1[1] * w[1];
            acc[6][0] += s1[2] * w[0]; acc[6][1] += s1[2] * w[1]; acc[7][0] += s1[3] * w[0]; acc[7][1] += s1[3] * w[1];
            acc[8][0] += s2[0] * w[0]; acc[8][1] += s2[0] * w[1];
        }
#pragma unroll
        for (int b = 0; b < 9; ++b) { red[(wid * 9 + b) * 128 + 2 * lane] = acc[b][0]; red[(wid * 9 + b) * 128 + 2 * lane + 1] = acc[b][1]; }
        __syncthreads();
        for (int idx = tid; idx < 9 * 128; idx += 512) { const int b = idx >> 7, n = idx & 127; float s = 0.f;
#pragma unroll
            for (int w = 0; w < 8; ++w) s += red[(w * 9 + b) * 128 + n];
            mods[((size_t)l * 9 + b) * NMODC + n0 + n] = s + P.b_mod[(size_t)l * NMODC + n0 + n]; }
        __syncthreads();
    }
    __syncthreads();
    conv_layer(P, 0, lds, tid, wid, lane);
}

__device__ __forceinline__ void norm_phase(const Ptrs& P, int l, int which, int wid, int lane) {
    const bool from_in = (l == 0 && which == 0);
    gcf X = (gcf)(P.ws + WS_X);
    gcf slat = from_in ? P.x : X, sctx = from_in ? P.ctx : X + (size_t)MLAT * DM;
    gb Hn = (gb)(P.ws + WS_HN);
    gcf g = P.g_norm + (size_t)(l * 3 + which) * DM;
    gcf mods = (gcf)(P.ws + WS_MODS) + (size_t)l * 9 * NMODC + (size_t)(3 * which) * DM;
    const int M = (l == 3 && which == 2) ? MLAT : MTOT;
    const int gw = P.bx * 8 + wid, NGW = P.G * 8;
    const bool pend = !from_in && which != 2;
    const int pl = which == 0 ? l - 1 : l, pidx = which == 0 ? 8 : (which == 1 ? 2 : 5);
    const float pgsc = which == 2 ? 1.0f : 0.5f;
    gcf pgate = (gcf)(P.ws + WS_MODS) + ((size_t)(pend ? pl : 0) * 9 + 8) * NMODC + (size_t)pidx * DM;
    gcf part = (gcf)(P.ws + WS_S + S_PART);
    f32x4 gg[4];
#pragma unroll
    for (int j = 0; j < 4; ++j) gg[j] = ((const GAS f32x4*)g)[lane + 64 * j];
    f32x4 vn[4];
#define NORM_XR(r) ((const GAS f32x4*)((r) < MLAT ? slat + (size_t)(r) * DM : sctx + (size_t)((r) - MLAT) * DM) + lane)
    if (gw < M) { const GAS f32x4* xr0 = NORM_XR(gw);
#pragma unroll
        for (int j = 0; j < 4; ++j) vn[j] = xr0[64 * j]; }
    int bcur = -1; f32x4 shv[4], scv[4];
#pragma unroll
    for (int j = 0; j < 4; ++j) { shv[j] = (f32x4){0.f, 0.f, 0.f, 0.f}; scv[j] = (f32x4){0.f, 0.f, 0.f, 0.f}; }
    for (int row = gw; row < M; row += NGW) {
        const int b = row < MLAT ? (row >> 12) : 8;
        if (b != bcur) { bcur = b;
#pragma unroll
            for (int j = 0; j < 4; ++j) { shv[j] = ((const GAS f32x4*)(mods + (size_t)b * NMODC))[lane + 64 * j]; scv[j] = ((const GAS f32x4*)(mods + (size_t)b * NMODC + DM))[lane + 64 * j] + 1.0f; } }
        f32x4 v[4]; float s = 0.f;
#pragma unroll
        for (int j = 0; j < 4; ++j) v[j] = vn[j];
        if (row + NGW < M) { const GAS f32x4* xr1 = NORM_XR(row + NGW);
#pragma unroll
            for (int j = 0; j < 4; ++j) vn[j] = xr1[64 * j]; }
#pragma unroll
        for (int j = 0; j < 4; ++j) s += (v[j][0] * v[j][0] + v[j][1] * v[j][1]) + (v[j][2] * v[j][2] + v[j][3] * v[j][3]);
        if (from_in) { GAS f32x4* xo = (GAS f32x4*)(P.ws + WS_X + (size_t)row * DM * 4) + lane;
#pragma unroll
            for (int j = 0; j < 4; ++j) xo[64 * j] = v[j]; }
        else if (pend && row >= MLAT) { GAS f32x4* xo = (GAS f32x4*)(P.ws + WS_X + (size_t)row * DM * 4) + lane; s = 0.f;
#pragma unroll
            for (int j = 0; j < 4; ++j) { f32x4 a = {0.f, 0.f, 0.f, 0.f};
#pragma unroll
                for (int p = 0; p < 8; ++p) a += ((const GAS f32x4*)(part + ((size_t)p * 2048 + (row - MLAT)) * DM))[lane + 64 * j];
                v[j] = v[j] + (((const GAS f32x4*)pgate)[lane + 64 * j] * pgsc) * a; xo[64 * j] = v[j];
                s += (v[j][0] * v[j][0] + v[j][1] * v[j][1]) + (v[j][2] * v[j][2] + v[j][3] * v[j][3]); } }
        const float rstd = 1.0f / sqrtf(wave_sum(s) * (1.0f / DM) + EPS);
        GAS u32x2* o8 = (GAS u32x2*)(Hn + (size_t)row * DM) + lane;
#pragma unroll
        for (int j = 0; j < 4; ++j) { const f32x4 hv = (v[j] * rstd) * gg[j] * scv[j] + shv[j];
            u32x2 w; w.x = pk2(hv[0], hv[1]); w.y = pk2(hv[2], hv[3]); o8[64 * j] = w; }
    }
#undef NORM_XR
}
__device__ __forceinline__ void mla_row_phase(const Ptrs& P, int l, int wid, int lane) {
    const int j = l / 3;
    gcf A = (gcf)(P.ws + WS_S + S_A); gb cqn = (gb)(P.ws + WS_S + S_CQN), ckvn = (gb)(P.ws + WS_S + S_CKVN), kr = (gb)(P.ws + WS_S + S_KR);
    gcf gq = P.a_g_q + (size_t)j * 384, gkv = P.a_g_kv + (size_t)j * 256; gcf tab = (gcf)(P.ws + WS_TAB);
    const int gw = P.bx * 8 + wid, NGW = P.G * 8;
    const bool qlane = lane < 48;
    f32x4 gq0 = {0.f, 0.f, 0.f, 0.f}, gq1 = {0.f, 0.f, 0.f, 0.f};
    if (qlane) { gq0 = *(const GAS f32x4*)(gq + 8 * lane); gq1 = *(const GAS f32x4*)(gq + 8 * lane + 4); }
    const f32x4 g4 = *(const GAS f32x4*)(gkv + 4 * lane);
    for (int row = gw; row < MTOT; row += NGW) {
        gcf a = A + (size_t)row * 768;
        f32x4 q0 = {0.f, 0.f, 0.f, 0.f}, q1 = {0.f, 0.f, 0.f, 0.f};
        if (qlane) { q0 = *(const GAS f32x4*)(a + 8 * lane); q1 = *(const GAS f32x4*)(a + 8 * lane + 4); }
        const f32x4 kv = *(const GAS f32x4*)(a + 384 + 4 * lane);
        const float s = ((q0[0] * q0[0] + q0[1] * q0[1]) + (q0[2] * q0[2] + q0[3] * q0[3])) + ((q1[0] * q1[0] + q1[1] * q1[1]) + (q1[2] * q1[2] + q1[3] * q1[3]));
        const float rq = 1.0f / sqrtf(wave_sum(s) * (1.0f / 384.0f) + EPS);
        if (qlane) { u32x4 w; w.x = pk2(q0[0] * rq * gq0[0], q0[1] * rq * gq0[1]); w.y = pk2(q0[2] * rq * gq0[2], q0[3] * rq * gq0[3]); w.z = pk2(q1[0] * rq * gq1[0], q1[1] * rq * gq1[1]); w.w = pk2(q1[2] * rq * gq1[2], q1[3] * rq * gq1[3]);
            *(GAS u32x4*)(cqn + (size_t)row * 384 + 8 * lane) = w; }
        const float rk = 1.0f / sqrtf(wave_sum((kv[0] * kv[0] + kv[1] * kv[1]) + (kv[2] * kv[2] + kv[3] * kv[3])) * (1.0f / 256.0f) + EPS);
        { u32x2 w; w.x = pk2(kv[0] * rk * g4[0], kv[1] * rk * g4[1]); w.y = pk2(kv[2] * rk * g4[2], kv[3] * rk * g4[3]); *(GAS u32x2*)(ckvn + (size_t)row * 256 + 4 * lane) = w; }
        const float mine = a[640 + lane]; const float other = __int_as_float(__builtin_amdgcn_ds_bpermute((lane ^ 16) << 2, __float_as_int(mine)));
        float outv = mine;
        if (row < MLAT) { const int t = row & (SEQ - 1), axis = lane >> 5, pos = axis ? (t & 63) : (t >> 6), i = lane & 15;
            const float c = tab[(pos * 16 + i) * 2], sn = tab[(pos * 16 + i) * 2 + 1];
            outv = (lane & 16) ? (mine * c + other * sn) : (mine * c - other * sn); }
        kr[(size_t)row * 64 + lane] = (bf16_t)f2bf(outv);
    }
}
__device__ __forceinline__ void diff_row_phase(const Ptrs& P, int wid, int lane) {
    gcb O2 = (gcb)(P.ws + WS_S + S_O2); gb On = (gb)(P.ws + WS_HN);
    gcf lp = P.b_lambda;
    const float lam = __expf(wave_sum(lp[lane] * lp[64 + lane])) - __expf(wave_sum(lp[128 + lane] * lp[192 + lane])) + LAM_INIT;
    const int sub = lane & 15, hq = lane >> 4;
    const f32x4 ga = *(const GAS f32x4*)(P.b_g_sub + 8 * sub), gb4 = *(const GAS f32x4*)(P.b_g_sub + 8 * sub + 4);
    const int gw = P.bx * 8 + wid, NGW = P.G * 8;
    for (int row = gw; row < MTOT; row += NGW) {
#pragma unroll
        for (int it = 0; it < 2; ++it) { const int h = hq + 4 * it;
            const u32x4 av = *(const GAS u32x4*)(O2 + (size_t)row * 2048 + (2 * h) * 128 + 8 * sub), bv = *(const GAS u32x4*)(O2 + (size_t)row * 2048 + (2 * h + 1) * 128 + 8 * sub);
            float d[8]; float ss = 0.f;
#pragma unroll
            for (int e = 0; e < 4; ++e) { d[2 * e] = __uint_as_float(av[e] << 16) - lam * __uint_as_float(bv[e] << 16); d[2 * e + 1] = __uint_as_float(av[e] & 0xffff0000u) - lam * __uint_as_float(bv[e] & 0xffff0000u);
                ss += d[2 * e] * d[2 * e] + d[2 * e + 1] * d[2 * e + 1]; }
#pragma unroll
            for (int o = 1; o < 16; o <<= 1) ss += __int_as_float(__builtin_amdgcn_ds_bpermute((lane ^ o) << 2, __float_as_int(ss)));
            const float r = 1.0f / sqrtf(ss * (1.0f / 128.0f) + EPS) * (1.0f - LAM_INIT);
            u32x4 w; w.x = pk2(d[0] * r * ga[0], d[1] * r * ga[1]); w.y = pk2(d[2] * r * ga[2], d[3] * r * ga[3]); w.z = pk2(d[4] * r * gb4[0], d[5] * r * gb4[1]); w.w = pk2(d[6] * r * gb4[2], d[7] * r * gb4[3]);
            *(GAS u32x4*)(On + (size_t)row * DM + h * 128 + 8 * sub) = w;
        }
    }
}
__device__ __forceinline__ void final_phase(const Ptrs& P, int wid, int lane) {
    gcf X = (gcf)(P.ws + WS_X);
    const int gw = P.bx * 8 + wid, NGW = P.G * 8;
    f32x4 gg[4];
#pragma unroll
    for (int j = 0; j < 4; ++j) gg[j] = ((const GAS f32x4*)P.g_final)[lane + 64 * j];
    f32x4 vn[4];
    if (gw < MLAT) { const GAS f32x4* xr0 = (const GAS f32x4*)(X + (size_t)gw * DM) + lane;
#pragma unroll
        for (int j = 0; j < 4; ++j) vn[j] = xr0[64 * j]; }
    for (int row = gw; row < MLAT; row += NGW) {
        f32x4 v[4]; float s = 0.f;
#pragma unroll
        for (int j = 0; j < 4; ++j) v[j] = vn[j];
        if (row + NGW < MLAT) { const GAS f32x4* xr1 = (const GAS f32x4*)(X + (size_t)(row + NGW) * DM) + lane;
#pragma unroll
            for (int j = 0; j < 4; ++j) vn[j] = xr1[64 * j]; }
#pragma unroll
        for (int j = 0; j < 4; ++j) s += (v[j][0] * v[j][0] + v[j][1] * v[j][1]) + (v[j][2] * v[j][2] + v[j][3] * v[j][3]);
        const float rstd = 1.0f / sqrtf(wave_sum(s) * (1.0f / DM) + EPS);
        GAS f32x4* op = (GAS f32x4*)(P.out + (size_t)row * DM) + lane;
#pragma unroll
        for (int j = 0; j < 4; ++j) op[64 * j] = (v[j] * rstd) * gg[j];
    }
}

template <int DQK, int DV, bool MLA, bool WINDOW, bool SINK>
__device__ __forceinline__ void attn_phase(LAS unsigned char* lds, gcb Q, int ldq, gcb K, int ldk, gcb Kr, gcb Vt, gb O, int ldo, int nheads, int kdiv, int vdiv, gcf sink, bool with_ctx_q, int vcu, int G) {
    constexpr int KCH = DQK / 8, KCHP = KCH + 1, KSTR = KCHP * 16, VCHP = 9, VSTR = VCHP * 16, KBUF = 64 * KSTR, VBUF = DV * VSTR;
    constexpr int KINST = KCHP, VINST = (DV * VCHP) / 64;
    constexpr int NDC = DQK / 16, NDVB = DV / 32, NKI = (KINST + 7) / 8, NVI = (VINST + 7) / 8;
    constexpr int NDMA = KINST / 8 + VINST / 8;
    LAS unsigned char* ldsK = lds; LAS unsigned char* ldsV = lds + 3 * KBUF;
    static_assert(3 * (KBUF + VBUF) <= 140 * 1024, "attention LDS ring");
    int tid_ = threadIdx.x; asm volatile("" : "+v"(tid_));
    const int tid = tid_, lane = tid & 63, r32 = lane & 31, hi = lane >> 5, wid = __builtin_amdgcn_readfirstlane(tid >> 6);
    const int nlat = NB * nheads * 16, nunits = nlat + (with_ctx_q ? NB * nheads : 0);
    const int pr = (r32 & 0x13) | ((r32 & 4) << 1) | ((r32 & 8) >> 1);
    int kc[NKI], ks[NKI], kh[NKI], vc[NVI];
#pragma unroll
    for (int i = 0; i < NKI; ++i) { const int q = (wid + 8 * i) * 64 + lane, row = q / KCHP, cp = q % KCHP, c = cp < KCH ? cp : 0;
        if (MLA) { if (c < 16) { kc[i] = row * 2048 + c * 16; ks[i] = 2048; kh[i] = 2; } else { kc[i] = (int)((const GAS unsigned char*)Kr - (const GAS unsigned char*)K) + row * 128 + (c - 16) * 16; ks[i] = 128; kh[i] = 0; } }
        else { kc[i] = row * ldk * 2 + c * 16; ks[i] = ldk * 2; kh[i] = 2; } }
#pragma unroll
    for (int i = 0; i < NVI; ++i) { const int q = (wid + 8 * i) * 64 + lane, dv = q / VCHP, cp = q % VCHP, c = cp < 8 ? cp : 0; vc[i] = dv * (MTOT * 2) + c * 16; }
    for (int u = vcu; u < nunits; u += G) {
        int bh, qblk; if (u < nlat) { bh = u >> 4; qblk = u & 15; } else { bh = u - nlat; qblk = 16; }
        const int head = bh % nheads, b = bh / nheads;
        const bool isctx = (qblk == 16);
        const int qrow0 = isctx ? MLAT + b * CTXL : b * SEQ + qblk * 256;
        int lt0 = 0, lt1 = isctx ? 0 : 64;
        if (WINDOW && !isctx) { int lo = qblk * 256 - 128; if (lo < 0) lo = 0; int hh = qblk * 256 + 384; if (hh > SEQ) hh = SEQ; lt0 = lo >> 6; lt1 = hh >> 6; }
        const int NT = 4 + (lt1 - lt0);
        const int kcol = (head / kdiv) * (MLA ? 128 : 64);
        const size_t vrow0 = (size_t)(head / vdiv) * DV;
        bf16x8 qf[NDC];
        { gcb qp = Q + (size_t)(qrow0 + wid * 32 + r32) * ldq + head * DQK + hi * 8;
#pragma unroll
          for (int dc = 0; dc < NDC; ++dc) qf[dc] = *(const GAS bf16x8*)(qp + dc * 16); }
        float m_run = -1e30f, l_run = 0.f;
        if (SINK) { m_run = sink[head] * LOG2E; l_run = hi == 0 ? 1.0f : 0.0f; }
        f32x16 o[NDVB]; const float zatt = opaque_zero();
#pragma unroll
        for (int d = 0; d < NDVB; ++d)
#pragma unroll
            for (int r = 0; r < 16; ++r) o[d][r] = zatt;
#define ATT_DMA(t, bf) do { const int t_ = (t), bf_ = (bf); const int krow_ = t_ < 4 ? MLAT + b * CTXL + 64 * t_ : b * SEQ + 64 * (lt0 + t_ - 4); \
        _Pragma("unroll") for (int i = 0; i < NKI; ++i) if (wid + 8 * i < KINST) { \
            const unsigned off = (unsigned)(kc[i] + kh[i] * kcol + krow_ * ks[i]); \
            __builtin_amdgcn_global_load_lds((const GAS unsigned*)((const GAS unsigned char*)K + off), (LAS unsigned*)(ldsK + bf_ * KBUF + (wid + 8 * i) * 1024), 16, 0, 0); } \
        _Pragma("unroll") for (int i = 0; i < NVI; ++i) if (wid + 8 * i < VINST) { \
            __builtin_amdgcn_global_load_lds((const GAS unsigned*)((const GAS unsigned char*)(Vt + vrow0 * MTOT + krow_) + (unsigned)vc[i]), (LAS unsigned*)(ldsV + bf_ * VBUF + (wid + 8 * i) * 1024), 16, 0, 0); } } while (0)
#define ATT_WAITBAR(N) asm volatile("s_waitcnt vmcnt(%0) lgkmcnt(0)\n\ts_barrier" :: "n"(N) : "memory")
#define ATT_QK(d0, d1, bf_, t_) do { \
            { f32x16 e0_, e1_;     \
            _Pragma("unroll") for (int r = 0; r < 16; ++r) { d0[r] = 0.f; d1[r] = 0.f; e0_[r] = 0.f; e1_[r] = 0.f; } \
            { const LAS unsigned char* kb0 = ldsK + (bf_) * KBUF + pr * KSTR + hi * 16; const LAS unsigned char* kb1 = kb0 + 32 * KSTR; \
              _Pragma("unroll") for (int dc = 0; dc < NDC; dc += 2) { \
                  const bf16x8 k0 = *(const LAS bf16x8*)(kb0 + dc * 32), k1 = *(const LAS bf16x8*)(kb1 + dc * 32), k2 = *(const LAS bf16x8*)(kb0 + dc * 32 + 32), k3 = *(const LAS bf16x8*)(kb1 + dc * 32 + 32); \
                  d0 = __builtin_amdgcn_mfma_f32_32x32x16_bf16(k0, qf[dc], d0, 0, 0, 0); d1 = __builtin_amdgcn_mfma_f32_32x32x16_bf16(k1, qf[dc], d1, 0, 0, 0); \
                  e0_ = __builtin_amdgcn_mfma_f32_32x32x16_bf16(k2, qf[dc + 1], e0_, 0, 0, 0); e1_ = __builtin_amdgcn_mfma_f32_32x32x16_bf16(k3, qf[dc + 1], e1_, 0, 0, 0); } } \
            _Pragma("unroll") for (int r = 0; r < 16; ++r) { d0[r] += e0_[r]; d1[r] += e1_[r]; } } \
            if (WINDOW && (t_) >= 4) { const int kbase = 64 * (lt0 + (t_) - 4) + 8 * hi - (qblk * 256 + wid * 32 + r32); \
                _Pragma("unroll") for (int r = 0; r < 16; ++r) { const int e0 = kbase + 16 * (r >> 3) + (r & 7), e1 = e0 + 32; \
                    if (e0 > 128 || e0 < -128) d0[r] = -1e30f; if (e1 > 128 || e1 < -128) d1[r] = -1e30f; } } } while (0)
        ATT_DMA(0, 0); ATT_DMA(1, 1);
        ATT_WAITBAR(0);
        int buf = 0, buf1 = 1, buf2 = 2;
        constexpr bool PIPE = false;
        f32x16 s0, s1;
        if (PIPE) ATT_QK(s0, s1, 0, 0);
#pragma unroll 1
        for (int t = 0; t < NT; ++t) {
            if (t + 2 < NT) ATT_DMA(t + 2, buf2);
            f32x16 n0, n1;
            if (PIPE) ATT_QK(n0, n1, buf1, t + 1);
            else ATT_QK(s0, s1, buf, t);
            float mxa = fmaxf(s0[0], s1[0]), mxb = fmaxf(s0[1], s1[1]), mxc = fmaxf(s0[2], s1[2]), mxd = fmaxf(s0[3], s1[3]);
#pragma unroll
            for (int r = 4; r < 16; r += 4) { mxa = fmaxf(mxa, fmaxf(s0[r], s1[r])); mxb = fmaxf(mxb, fmaxf(s0[r + 1], s1[r + 1])); mxc = fmaxf(mxc, fmaxf(s0[r + 2], s1[r + 2])); mxd = fmaxf(mxd, fmaxf(s0[r + 3], s1[r + 3])); }
            float mx = half_max(fmaxf(fmaxf(mxa, mxb), fmaxf(mxc, mxd)));
            if (__builtin_amdgcn_ballot_w64(mx - m_run > 8.0f) != 0ull) {
                const float m_new = fmaxf(m_run, mx), alpha = fast_exp2(m_run - m_new); m_run = m_new; l_run *= alpha;
#pragma unroll
                for (int d = 0; d < NDVB; ++d)
#pragma unroll
                    for (int r = 0; r < 16; ++r) o[d][r] *= alpha;
            }
            float lsa = 0.f, lsb = 0.f, lsc = 0.f, lsd = 0.f;
#pragma unroll
            for (int r = 0; r < 16; r += 2) { s0[r] = fast_exp2(s0[r] - m_run); s1[r] = fast_exp2(s1[r] - m_run); s0[r + 1] = fast_exp2(s0[r + 1] - m_run); s1[r + 1] = fast_exp2(s1[r + 1] - m_run);
                lsa += s0[r]; lsb += s1[r]; lsc += s0[r + 1]; lsd += s1[r + 1]; }
            l_run += (lsa + lsb) + (lsc + lsd);
            bf16x8 pf[4];
            { u32x4 w;
              w.x = pk2(s0[0], s0[1]); w.y = pk2(s0[2], s0[3]); w.z = pk2(s0[4], s0[5]); w.w = pk2(s0[6], s0[7]); pf[0] = __builtin_bit_cast(bf16x8, w);
              w.x = pk2(s0[8], s0[9]); w.y = pk2(s0[10], s0[11]); w.z = pk2(s0[12], s0[13]); w.w = pk2(s0[14], s0[15]); pf[1] = __builtin_bit_cast(bf16x8, w);
              w.x = pk2(s1[0], s1[1]); w.y = pk2(s1[2], s1[3]); w.z = pk2(s1[4], s1[5]); w.w = pk2(s1[6], s1[7]); pf[2] = __builtin_bit_cast(bf16x8, w);
              w.x = pk2(s1[8], s1[9]); w.y = pk2(s1[10], s1[11]); w.z = pk2(s1[12], s1[13]); w.w = pk2(s1[14], s1[15]); pf[3] = __builtin_bit_cast(bf16x8, w); }
            { const LAS unsigned char* vb = ldsV + buf * VBUF + r32 * VSTR + hi * 16;
#pragma unroll
              for (int c = 0; c < 4; ++c)
#pragma unroll
                  for (int d = 0; d < NDVB; ++d) { const bf16x8 vf = *(const LAS bf16x8*)(vb + d * 32 * VSTR + c * 32); o[d] = __builtin_amdgcn_mfma_f32_32x32x16_bf16(vf, pf[c], o[d], 0, 0, 0); } }
            if (PIPE || t + 2 >= NT) ATT_WAITBAR(0); else ATT_WAITBAR(NDMA);
            if (PIPE) { s0 = n0; s1 = n1; }
            buf = buf1; buf1 = buf2; buf2 = buf2 == 2 ? 0 : buf2 + 1;
        }
#undef ATT_QK
#undef ATT_DMA
#undef ATT_WAITBAR
        const float inv = 1.0f / half_sum(l_run);
        gb op = O + (size_t)(qrow0 + wid * 32 + r32) * ldo + head * DV + 8 * hi;
#pragma unroll
        for (int d = 0; d < NDVB; ++d)
#pragma unroll
            for (int p = 0; p < 2; ++p) {
                const unsigned ax = pk2(o[d][8 * p] * inv, o[d][8 * p + 1] * inv), ay = pk2(o[d][8 * p + 2] * inv, o[d][8 * p + 3] * inv);
                const unsigned bx = pk2(o[d][8 * p + 4] * inv, o[d][8 * p + 5] * inv), by = pk2(o[d][8 * p + 6] * inv, o[d][8 * p + 7] * inv);
                const auto r1 = __builtin_amdgcn_permlane32_swap(ax, bx, false, false), r2 = __builtin_amdgcn_permlane32_swap(ay, by, false, false);
                u32x4 w; w.x = r1[0]; w.y = r2[0]; w.z = r1[1]; w.w = r2[1];
                *(GAS u32x4*)(op + 32 * d + 16 * p) = w; }
    }
}

#define XB_TMO      128
#define XB_XCNT(j)  (256  + 64 * (j))
#define XB_XSUB(j)  (1280 + 64 * (j))
#define XB_XGEN(j)  (2304 + 64 * (j))
#define XB_TOP      3328
#define XB_TOPGEN   3392
#define XCD_BAR_WORDS 3456
#define XB_SPIN_CAP (1u << 21)

__device__ __forceinline__ unsigned xb_ld(unsigned* p)              { return __hip_atomic_load(p, __ATOMIC_RELAXED, __HIP_MEMORY_SCOPE_AGENT); }
__device__ __forceinline__ unsigned xb_add(unsigned* p, unsigned v) { return __hip_atomic_fetch_add(p, v, __ATOMIC_RELAXED, __HIP_MEMORY_SCOPE_AGENT); }
__device__ __forceinline__ unsigned xb_xcc_id() { return (unsigned)__builtin_amdgcn_s_getreg((3 << 11) | 20) & 0xFu; }
#define XB_SPIN(cond, bar) do { unsigned _sp = 0; while (cond) { __builtin_amdgcn_s_sleep(1); \
    if ((++_sp & 255u) == 0u) { if (xb_ld(&(bar)[XB_TMO])) break; if (_sp > XB_SPIN_CAP) { atomicAdd(&(bar)[XB_TMO], 1u); break; } } } } while (0)

struct XcdBarrier {
    unsigned* bar; unsigned x;
    volatile LAS unsigned* st;
};

__device__ __forceinline__ XcdBarrier xcd_barrier_post(unsigned* bar, volatile LAS unsigned* st) {
    XcdBarrier b; b.bar = bar; b.x = xb_xcc_id(); b.st = st;
    if (threadIdx.x == 0) (void)xb_add(&bar[XB_XCNT(b.x)], 1u);
    return b;
}
__device__ __forceinline__ void xcd_barrier_complete(unsigned* bar, unsigned x, unsigned& nloc, unsigned& nx) {
    const unsigned G = gridDim.x * gridDim.y * gridDim.z;
    unsigned sum, cnt, mine, sp = 0u;
    for (;;) {
        sum = 0u; cnt = 0u; mine = 0u;
#pragma unroll
        for (unsigned j = 0; j < 16; ++j) { const unsigned c = xb_ld(&bar[XB_XCNT(j)]); sum += c; cnt += (c > 0u) ? 1u : 0u; mine = (j == x) ? c : mine; }
        if (sum == G) break;
        __builtin_amdgcn_s_sleep(1);
        if ((++sp & 255u) == 0u) { if (xb_ld(&bar[XB_TMO])) break; if (sp > XB_SPIN_CAP) { atomicAdd(&bar[XB_TMO], 1u); break; } }
    }
    nloc = mine > 0u ? mine : 1u; nx = cnt > 0u ? cnt : 1u;
}

__device__ __forceinline__ void xcd_barrier(const XcdBarrier& b) {
    asm volatile("s_waitcnt vmcnt(0)" ::: "memory");
    __syncthreads();
    if (threadIdx.x == 0) {
        unsigned* bar = b.bar;
        __builtin_amdgcn_s_waitcnt(0);
        unsigned nloc = b.st[0], nx = b.st[1];
        if (nloc == 0u) { xcd_barrier_complete(bar, b.x, nloc, nx); b.st[0] = nloc; b.st[1] = nx; }
        const unsigned old = xb_add(&bar[XB_XSUB(b.x)], 1u);
        const unsigned gen = old / nloc;
        if (old + 1u == (gen + 1u) * nloc) {
            __builtin_amdgcn_fence(__ATOMIC_RELEASE, "agent");
            asm volatile("s_waitcnt vmcnt(0)" ::: "memory");
            const unsigned og = xb_add(&bar[XB_TOP], 1u);
            const unsigned tg = og / nx;
            if (og + 1u == (tg + 1u) * nx) xb_add(&bar[XB_TOPGEN], 1u);
            else XB_SPIN(xb_ld(&bar[XB_TOPGEN]) == tg, bar);
            __builtin_amdgcn_fence(__ATOMIC_ACQUIRE, "agent");
            xb_add(&bar[XB_XGEN(b.x)], 1u);
            asm volatile("s_waitcnt vmcnt(0)" ::: "memory");
        } else {
            XB_SPIN(xb_ld(&bar[XB_XGEN(b.x)]) == gen, bar);
            __builtin_amdgcn_fence(__ATOMIC_ACQUIRE, "agent");
            asm volatile("s_waitcnt vmcnt(0)" ::: "memory");
        }
    }
    __syncthreads();
}

#define KARG(i) ((gcf)(*(const __attribute__((address_space(4))) unsigned long long*)(kp + 8 * (i))))
#define PHASE_BEGIN int tid_ = threadIdx.x; asm volatile("" : "+v"(tid_)); const int tid = tid_, lane = tid & 63, wid = __builtin_amdgcn_readfirstlane(tid >> 6); const __attribute__((address_space(4))) unsigned char* kp = (const __attribute__((address_space(4))) unsigned char*)__builtin_amdgcn_kernarg_segment_ptr(); asm volatile("" : "+s"(kp)); int G = gridDim.x, bx = __builtin_amdgcn_readfirstlane((int)MISC[5]); asm volatile("" : "+s"(G), "+s"(bx)); const int vcu = __builtin_amdgcn_readfirstlane((int)MISC[4]); Ptrs P; P.bx = bx; P.G = G; P.x = KARG(0); P.c = KARG(1); P.ctx = KARG(2); P.c_ctx = KARG(3); P.w_mod = KARG(4); P.b_mod = KARG(5); P.g_norm = KARG(6); P.w_ffn_in = KARG(7); P.w_ffn_out = KARG(8); P.a_w_in = KARG(9); P.a_g_q = KARG(10); P.a_g_kv = KARG(11); P.a_w_qb = KARG(12); P.a_w_kvb = KARG(13); P.a_w_o = KARG(14); P.b_w_qkv = KARG(15); P.b_lambda = KARG(16); P.b_g_sub = KARG(17); P.b_w_o = KARG(18); P.c_w_qkv = KARG(19); P.c_sink = KARG(20); P.c_w_o = KARG(21); P.g_final = KARG(22); P.out = (gf)KARG(23); P.ws = (GAS unsigned char*)KARG(24);
struct Args { const float* in[23]; float* out; unsigned char* ws; int ph_lo, ph_hi; };

__global__ void __launch_bounds__(512, 2) fwd_kernel(Args args) {
    extern __shared__ __attribute__((aligned(16))) unsigned char lds_raw[];
    LAS unsigned char* lds = (LAS unsigned char*)lds_raw;
    cg::grid_group grid = cg::this_grid();
    volatile LAS unsigned* MISC = (volatile LAS unsigned*)(lds + 143360 + 512);
    if (threadIdx.x < 8) MISC[threadIdx.x] = 0u;
    __syncthreads();
    if (threadIdx.x == 0) {
        const unsigned x = xb_xcc_id(); unsigned* bar0 = (unsigned*)(args.ws + WS_BAR);
        const unsigned rank = xb_add(&bar0[XB_XCNT(x)], 1u);
        const unsigned G0 = gridDim.x, bx0 = blockIdx.x;
        MISC[2] = rank; MISC[3] = x; MISC[4] = (G0 % 8 == 0) ? (bx0 % 8) * (G0 / 8) + bx0 / 8 : bx0; MISC[5] = bx0;
    }
    __syncthreads();

    for (int ph = args.ph_lo; ph < args.ph_hi; ++ph) {
        const unsigned pw = __builtin_amdgcn_readfirstlane(PROG_D.e[ph]);
        const int op = pw & 0xff, l = (pw >> 8) & 0xff, sraw = (pw >> 16) & 0xff, s = sraw & 3, rep = sraw >> 7;
#ifdef ONLY_OP
        if (op != ONLY_OP) continue;
#endif
        const int kind = l % 3;
#ifdef ONLY_KIND
        if (kind != ONLY_KIND) continue;
#endif
#define PHASE_LOCALS gcb Wl = (gcb)(P.ws + WS_W0 + (size_t)(l & 1) * WS_WSZ); gcb HN = (gcb)(P.ws + WS_HN); GAS unsigned char* Sb = P.ws + WS_S; gcf tab = (gcf)(P.ws + WS_TAB); gcf modl = (gcf)(P.ws + WS_MODS) + (size_t)l * 9 * NMODC; gf X = (gf)(P.ws + WS_X); \
        (void)Wl; (void)HN; (void)Sb; (void)tab; (void)modl; (void)X; (void)tid; (void)lane; (void)wid; (void)vcu;
        switch (op) {
        case OP_PRO: { PHASE_BEGIN PHASE_LOCALS prologue(P, lds, tid, wid, lane); } break;
        case OP_NORM: { PHASE_BEGIN PHASE_LOCALS
            norm_phase(P, l, s, wid, lane);
            if (s == 0 && l + 1 < 4) conv_layer(P, l + 1, lds, tid, wid, lane);
        } break;
        case OP_FFN_IN: { PHASE_BEGIN PHASE_LOCALS
            const int M = (l == 3 && s == 1) ? MLAT : MTOT;
            EpiSwiglu E{(gb)(Sb + S_HH)};
            run_gemm(lds, G, bx, HN, Wl + (s ? OFF_WIN1 : OFF_WIN0), M, 2 * DFF, DM, E);
        } break;
        case OP_FFN_OUT: case OP_MIX_OUT: { PHASE_BEGIN PHASE_LOCALS
            const bool ffn = (op == OP_FFN_OUT);
            const int M = (l == 3 && (!ffn || s == 1)) ? MLAT : MTOT;
            EpiResid E{(gcf)X, (gcf)(X + (size_t)MLAT * DM), X, modl + (size_t)(ffn ? (s ? 8 : 2) : 5) * DM, rep ? 0u : (ffn ? 0x3f000000u : 0x3f800000u)};
            gcb A = ffn ? (gcb)(Sb + S_HH) : HN;
            gcb Bt = ffn ? Wl + (s ? OFF_WOUT1 : OFF_WOUT0) : Wl + OFF_MIX + (kind == 0 ? MLA_WO : kind == 1 ? DIF_WO : SWA_WO);
            run_gemm(lds, G, bx, A, Bt, M, DM, ffn ? DFF : DM, E, ffn && (!rep || PROBE_SKIP_EPI));
        } break;
        case OP_MLA_IN: { PHASE_BEGIN PHASE_LOCALS
            EpiF32 E{(gf)(Sb + S_A), 768};
            run_gemm(lds, G, bx, HN, Wl + OFF_MIX + MLA_WA, MTOT, 768, DM, E);
        } break;
        case OP_MLA_ROW: { PHASE_BEGIN PHASE_LOCALS mla_row_phase(P, l, wid, lane); } break;
        case OP_PROJ: { PHASE_BEGIN PHASE_LOCALS
            if (kind == 0) {
                { EpiRope E{(gb)(Sb + S_Q), 1536, 192, 128, 1536, 0.07216878364870322f * LOG2E, tab};
                  run_gemm(lds, G, bx, (gcb)(Sb + S_CQN), Wl + OFF_MIX + MLA_WQB, MTOT, 1536, 384, E); }
                { EpiStoreBf16 E{(gb)(Sb + S_KN), 1024};
                  run_gemm(lds, G, bx, (gcb)(Sb + S_CKVN), Wl + OFF_MIX + MLA_WKN, MTOT, 1024, 256, E); }
                { EpiStoreBf16 E{(gb)(Sb + S_VT_MLA), MTOT};
                  run_gemm(lds, G, bx, Wl + OFF_MIX + MLA_WVT, (gcb)(Sb + S_CKVN), 1024, MTOT, 256, E); }
            } else {
                const int nqk = kind == 1 ? 2048 : 1280, nv = kind == 1 ? 1024 : 256;
                { EpiRope E{(gb)(Sb + S_QK), nqk, 64, 0, 1024, 0.125f * LOG2E, tab};
                  run_gemm(lds, G, bx, HN, Wl + OFF_MIX + (kind == 1 ? DIF_WQK : SWA_WQK), MTOT, nqk, DM, E); }
                { EpiStoreBf16 E{(gb)(Sb + (kind == 1 ? S_VT_DIFF : S_VT_SWA)), MTOT};
                  run_gemm(lds, G, bx, Wl + OFF_MIX + (kind == 1 ? DIF_WV : SWA_WV), HN, nv, MTOT, DM, E); }
            }
        } break;
        case OP_ATT: { PHASE_BEGIN PHASE_LOCALS
            if (kind == 0)
                attn_phase<192, 128, true, false, false>(lds, (gcb)(Sb + S_Q), 1536, (gcb)(Sb + S_KN), 1024, (gcb)(Sb + S_KR), (gcb)(Sb + S_VT_MLA), (gb)(P.ws + WS_HN), 1024, 8, 1, 1, P.c_sink, l < 3, vcu, G);
            else if (kind == 1)
                attn_phase<64, 128, false, false, false>(lds, (gcb)(Sb + S_QK), 2048, (gcb)(Sb + S_QK) + 1024, 2048, (gcb)(Sb + S_QK), (gcb)(Sb + S_VT_DIFF), (gb)(Sb + S_O2), 2048, 16, 1, 2, P.c_sink, true, vcu, G);
            else
                attn_phase<64, 64, false, true, true>(lds, (gcb)(Sb + S_QK), 1280, (gcb)(Sb + S_QK) + 1024, 1280, (gcb)(Sb + S_QK), (gcb)(Sb + S_VT_SWA), (gb)(P.ws + WS_HN), 1024, 16, 4, 4, P.c_sink, true, vcu, G);
        } break;
        case OP_DIFF_ROW: { PHASE_BEGIN PHASE_LOCALS diff_row_phase(P, wid, lane); } break;
        case OP_FINAL: { PHASE_BEGIN PHASE_LOCALS final_phase(P, wid, lane); } break;
        default: break;
        }
        __syncthreads();
        if (ph + 1 < args.ph_hi) {
            if (ph == 0) { grid.sync();
                if (threadIdx.x == 0) {
                    unsigned* bar0 = (unsigned*)(args.ws + WS_BAR); const unsigned x = MISC[3], rank = MISC[2], G0 = gridDim.x;
                    unsigned pre = 0u, idx = 0u, nx = 0u; bool uni = true;
                    for (unsigned j = 0; j < 16; ++j) { const unsigned cj = xb_ld(&bar0[XB_XCNT(j)]); if (j < x) { pre += cj; idx += cj ? 1u : 0u; } if (cj) { ++nx; if (cj * 8u != G0) uni = false; } }
                    if (nx == 8u && uni) { MISC[4] = pre + rank; MISC[5] = rank * 8u + idx; }
                }
                __syncthreads(); }
            else { XcdBarrier b; b.bar = (unsigned*)(args.ws + WS_BAR); b.x = xb_xcc_id(); b.st = MISC; xcd_barrier(b); if (DUP_SYNC) xcd_barrier(b); }
        }
    }
}

#ifndef N_LAUNCH_MODE
#define N_LAUNCH_MODE 1
#endif
extern "C" void kernel_launch(void* const* d_in, const int* in_sizes, int n_in, void* d_out, int out_size, void* d_ws, size_t ws_size, hipStream_t stream) {
    static int grid = 0;
    if (grid == 0) {
        if (n_in != 23 || out_size != MLAT * DM || ws_size < WS_END) { fprintf(stderr, "kernel_launch: unexpected problem (n_in %d out %d ws %zu need %zu)\n", n_in, out_size, ws_size, (size_t)WS_END); grid = -1; return; }
        int dev = 0, cus = 0, per_cu = 0;
        hipGetDevice(&dev); hipDeviceGetAttribute(&cus, hipDeviceAttributeMultiprocessorCount, dev);
        if (hipFuncSetAttribute((const void*)fwd_kernel, hipFuncAttributeMaxDynamicSharedMemorySize, LDS_BYTES) != hipSuccess) { fprintf(stderr, "kernel_launch: hipFuncSetAttribute failed\n"); grid = -1; return; }
        if (hipOccupancyMaxActiveBlocksPerMultiprocessor(&per_cu, (const void*)fwd_kernel, 512, LDS_BYTES) != hipSuccess || per_cu < 1) { fprintf(stderr, "kernel_launch: occupancy query gave %d\n", per_cu); per_cu = 1; }
        (void)hipGetLastError();
        grid = cus * 1;
    }
    if (grid < 0) return;
    if (hipMemsetAsync((char*)d_ws + WS_BAR, 0, BAR_ZERO_BYTES, stream) != hipSuccess) { fprintf(stderr, "kernel_launch: memset of barrier words failed\n"); return; }
    Args a{};
    for (int i = 0; i < 23; ++i) a.in[i] = (const float*)d_in[i];
    a.out = (float*)d_out; a.ws = (unsigned char*)d_ws;
#if N_LAUNCH_MODE == 1
    a.ph_lo = 0; a.ph_hi = NPHASE;
    { void* kargs[] = {&a}; hipError_t e = hipLaunchCooperativeKernel((const void*)fwd_kernel, dim3(grid), dim3(512), kargs, LDS_BYTES, stream);
      if (e != hipSuccess) fprintf(stderr, "cooperative launch failed: %s (grid %d)\n", hipGetErrorString(e), grid); }
#else
    for (int ph = 0; ph < NPHASE; ++ph) { a.ph_lo = ph; a.ph_hi = ph + 1; void* kargs[] = {&a};
        hipError_t e = hipLaunchCooperativeKernel((const void*)fwd_kernel, dim3(grid), dim3(512), kargs, LDS_BYTES, stream);
        if (e != hipSuccess) { fprintf(stderr, "launch %d failed: %s\n", ph, hipGetErrorString(e)); break; } }
#endif
}
```

```cpp
#include <hip/hip_runtime.h>
#include <hip/hip_cooperative_groups.h>
#include <cstdio>
#include <cstdint>
namespace cg = cooperative_groups;
__device__ __forceinline__ float opaque_zero() { float z; asm volatile("v_mov_b32 %0, 0" : "=v"(z)); return z; }
namespace pg8 {
#define PG8_LAS __attribute__((address_space(3)))
typedef unsigned short bf16_t;
typedef short bf16x8 __attribute__((ext_vector_type(8)));
typedef float f32x4 __attribute__((ext_vector_type(4)));
typedef unsigned u32x4 __attribute__((ext_vector_type(4)));
constexpr int BM = 256, BK = 64, HALF = 128, HTB = HALF * BK * 2  , STAGE_BYTES = 8 * HTB, NXCD = 8, WGM = 8;

__host__ __device__ __forceinline__ int lds_byte(int r, int c) { const int st = (r >> 4) * 2 + (c >> 5), rr = r & 15, cc = c & 31, ob = rr * 64 + cc * 2; return st * 1024 + (ob ^ (((ob >> 9) & 1) << 5)); }
__host__ __device__ __forceinline__ void stage_rc(int b, int& R, int& C) { const int st = b / 1024, sb = b % 1024, swz = sb ^ (((sb >> 9) & 1) << 5); R = (st >> 1) * 16 + swz / 64; C = (st & 1) * 32 + (swz % 64) / 2; }
__host__ __device__ __forceinline__ int perm32(int rho) { const int n = rho >> 4, i = rho & 15; return 8 * (i >> 2) + 4 * n + (i & 3); }

struct Unit { int pm, pn, k0, nt, split; };
struct Gemm { const bf16_t* A; const bf16_t* Bt; int M, N, K; };

struct StaticOrder {
    int nM, nN, nwg, G, c, ntk, nfull, L, P;
    __host__ __device__ void init(int M, int N, int G_, int c_, int ntk_, bool split) {
        nM = M / BM; nN = N / BM; G = G_; c = c_; ntk = ntk_; L = 0; P = 1;
        if (split && nM == 136 && (128 * nN) % G == 0 && G % (8 * nN) == 0 && G / (8 * nN) <= ntk / 2) { nM = 128; L = 8 * nN; P = G / L; }
        nwg = nM * nN; nfull = nwg;
    }
    __host__ __device__ void map(int wgid, Unit& u) const {
        { const int q = nwg / NXCD, r = nwg % NXCD, xcd = wgid % NXCD, off = wgid / NXCD; wgid = (xcd < r ? xcd * (q + 1) : r * (q + 1) + (xcd - r) * q) + off; }
        const int nig = WGM * nN, gid = wgid / nig, fm = gid * WGM, gsz = (nM - fm) < WGM ? (nM - fm) : WGM;
        u.pm = fm + ((wgid % nig) % gsz); u.pn = (wgid % nig) / gsz;
    }
    __host__ __device__ bool next(int i, Unit& u) const {
        if (L > 0 && (c & 1)) { if (i == 0) { if (c >= L * P) return false; goto piece; } --i; if ((long)i * G + c >= nfull) return false; }
        { const long Lid = (long)i * G + c;
          if (Lid < nfull) { map((int)Lid, u); u.k0 = 0; u.nt = ntk; u.split = 0; return true; } }
        if (L == 0 || i != nfull / G || c >= L * P) return false;
        piece:
        const int j = c / P, piece = c % P, pairs = ntk / 2, base = pairs / P, rem = pairs % P;
        u.pm = 128 + j / nN; u.pn = j % nN;
        u.k0 = 2 * (piece * base + (piece < rem ? piece : rem)); u.nt = 2 * (base + (piece < rem ? 1 : 0)); u.split = piece + 1; return true;
    }
    __device__ __forceinline__ void a_ready(const Unit&) const {}
    __device__ __forceinline__ void done(const Unit&) const {}
};

template <class Epi, class Sched, bool ALIGN_EPI = false, bool SP2 = false>
__device__ __forceinline__ void gemm_phase(PG8_LAS unsigned char* lds, const Gemm g, const Sched& S, const Epi& E) {
    int tid_ = threadIdx.x; asm volatile("" : "+v"(tid_));
    const int tid = tid_, wid = __builtin_amdgcn_readfirstlane(tid >> 6), lane = tid & 63, wr = wid >> 2, wc = wid & 3, fr = lane & 15, fq = lane >> 4;
    const int K = g.K, nt = K / BK;
    unsigned voffA[2], voffB[2];
#pragma unroll
    for (int i = 0; i < 2; ++i) { int R, C; stage_rc(tid * 16 + i * 8192, R, C); const int Rb = Epi::PERM ? ((R & ~31) + perm32(R & 31)) : R;
        voffA[i] = (unsigned)(R * K + C) * 2u; voffB[i] = (unsigned)(Rb * K + C) * 2u; }
    const size_t kstep = (size_t)(BK * 2);
    const size_t hstep = (size_t)HALF * K * 2;
    const size_t tstep = 2 * hstep;
    const unsigned ldsw = (unsigned)wid * 1024u;
    const int aoff = lds_byte(wr * 64 + fr, fq * 8), boff = lds_byte(wc * 32 + fr, fq * 8);
#define PG8_SA(b, h) (((b) * 2 + (h)) * HTB)
#define PG8_SB(b, h) ((4 + (b) * 2 + (h)) * HTB)
#define PG8_STAGE(bufoff, gbase, voff) do { _Pragma("unroll") for (int _i = 0; _i < 2; ++_i) \
        __builtin_amdgcn_global_load_lds((const unsigned*)((const char*)(gbase) + (voff)[_i]), (PG8_LAS unsigned*)(lds + (bufoff) + ldsw + _i * 8192), 16, 0, 0); } while (0)
#define PG8_LDA(dst, b, h) do { _Pragma("unroll") for (int m = 0; m < 4; ++m) _Pragma("unroll") for (int k = 0; k < 2; ++k) dst[m][k] = *(const PG8_LAS bf16x8*)(lds + PG8_SA(b, h) + aoff + m * 2048 + k * 1024); } while (0)
#define PG8_LDB(dst, b, h) do { _Pragma("unroll") for (int n = 0; n < 2; ++n) _Pragma("unroll") for (int k = 0; k < 2; ++k) dst[n][k] = *(const PG8_LAS bf16x8*)(lds + PG8_SB(b, h) + boff + n * 2048 + k * 1024); } while (0)
#define PG8_MMA(ai, bj, At, Bt) do { __builtin_amdgcn_s_setprio(1); _Pragma("unroll") for (int m = 0; m < 4; ++m) _Pragma("unroll") for (int n = 0; n < 2; ++n) _Pragma("unroll") for (int k = 0; k < 2; ++k) \
        acc[ai][bj][m][n] = __builtin_amdgcn_mfma_f32_16x16x32_bf16(Bt[n][k], At[m][k], acc[ai][bj][m][n], 0, 0, 0); __builtin_amdgcn_s_setprio(0); } while (0)
#define PG8_WAIT_V(n) asm volatile("s_waitcnt vmcnt(" #n ")" ::: "memory")
#define PG8_WAIT_L(n) asm volatile("s_waitcnt lgkmcnt(" #n ")" ::: "memory")
#define PG8_BAR __builtin_amdgcn_s_barrier()
#define PG8_SCHED __builtin_amdgcn_sched_barrier(0)
    Unit cur, nxt; int ui = 0;
    if (!S.next(0, cur)) return;
    f32x4 acc[2][2][4][2];
#pragma unroll
    for (int a = 0; a < 2; ++a)
#pragma unroll
        for (int b = 0; b < 2; ++b)
#pragma unroll
            for (int m = 0; m < 4; ++m)
#pragma unroll
                for (int n = 0; n < 2; ++n) { const float z0_ = opaque_zero(); acc[a][b][m][n] = (f32x4){z0_, z0_, z0_, z0_}; }
    bf16x8 At[4][2], B0[2][2], B1[2][2];
    const char* cA = (const char*)g.A + (size_t)cur.pm * tstep + (size_t)cur.k0 * kstep; const char* cB = (const char*)g.Bt + (size_t)cur.pn * tstep + (size_t)cur.k0 * kstep;
    S.a_ready(cur);
    if constexpr (SP2) {
        PG8_STAGE(PG8_SB(0, 0), cB, voffB); PG8_STAGE(PG8_SB(0, 1), cB + hstep, voffB); PG8_STAGE(PG8_SA(0, 0), cA, voffA); PG8_STAGE(PG8_SA(0, 1), cA + hstep, voffA);
        if (wr == 1) PG8_BAR;
        PG8_WAIT_V(2); PG8_BAR;
        PG8_STAGE(PG8_SB(1, 0), cB + kstep, voffB); PG8_STAGE(PG8_SA(1, 0), cA + kstep, voffA); PG8_STAGE(PG8_SB(1, 1), cB + hstep + kstep, voffB);
        PG8_WAIT_V(6); PG8_BAR;
    } else {
        PG8_STAGE(PG8_SB(0, 0), cB, voffB); PG8_STAGE(PG8_SA(0, 0), cA, voffA); PG8_STAGE(PG8_SB(0, 1), cB + hstep, voffB); PG8_STAGE(PG8_SA(0, 1), cA + hstep, voffA);
        if (wr == 1) PG8_BAR;
        PG8_WAIT_V(4); PG8_BAR;
        PG8_STAGE(PG8_SB(1, 0), cB + kstep, voffB); PG8_STAGE(PG8_SA(1, 0), cA + kstep, voffA); PG8_STAGE(PG8_SB(1, 1), cB + hstep + kstep, voffB);
        PG8_WAIT_V(6); PG8_BAR;
    }
    for (;;) {
        const bool has_next = S.next(ui + 1, nxt);
        const char* nA = has_next ? (const char*)g.A + (size_t)nxt.pm * tstep + (size_t)nxt.k0 * kstep : cA; const char* nB = has_next ? (const char*)g.Bt + (size_t)nxt.pn * tstep + (size_t)nxt.k0 * kstep : cB;
        const int nt_u = cur.nt;
        for (int t = 0; t < nt_u; t += 2) {
            const bool last = (t == nt_u - 2);
            const char* a1 = cA + (size_t)(t + 1) * kstep;
            const char* a2 = last ? nA : cA + (size_t)(t + 2) * kstep; const char* b2 = last ? nB : cB + (size_t)(t + 2) * kstep;
            const char* a3 = a2 + kstep; const char* b3 = b2 + kstep;
            if (last && has_next) S.a_ready(nxt);
            if constexpr (SP2) {
            PG8_LDB(B0, 0, 0); PG8_LDB(B1, 0, 1); PG8_SCHED; PG8_LDA(At, 0, 0); PG8_STAGE(PG8_SA(1, 1), a1 + hstep, voffA);
            PG8_WAIT_V(8); PG8_WAIT_L(0); PG8_BAR; PG8_MMA(0, 0, At, B0); PG8_MMA(0, 1, At, B1); PG8_BAR; PG8_SCHED;
            PG8_LDA(At, 0, 1); PG8_STAGE(PG8_SB(0, 0), b2, voffB); PG8_STAGE(PG8_SB(0, 1), b2 + hstep, voffB); PG8_STAGE(PG8_SA(0, 0), a2, voffA);
            PG8_WAIT_V(8); PG8_WAIT_L(0); PG8_BAR; PG8_MMA(1, 0, At, B0); PG8_MMA(1, 1, At, B1); PG8_BAR; PG8_SCHED;
            PG8_LDB(B0, 1, 0); PG8_LDB(B1, 1, 1); PG8_SCHED; PG8_LDA(At, 1, 0); PG8_STAGE(PG8_SA(0, 1), a2 + hstep, voffA);
            PG8_WAIT_V(8); PG8_WAIT_L(0); PG8_BAR; PG8_MMA(0, 0, At, B0); PG8_MMA(0, 1, At, B1); PG8_BAR; PG8_SCHED;
            PG8_LDA(At, 1, 1); PG8_STAGE(PG8_SB(1, 0), b3, voffB); PG8_STAGE(PG8_SB(1, 1), b3 + hstep, voffB); PG8_STAGE(PG8_SA(1, 0), a3, voffA);
            PG8_WAIT_V(8); PG8_WAIT_L(0); PG8_BAR; PG8_MMA(1, 0, At, B0); PG8_MMA(1, 1, At, B1); PG8_BAR; PG8_SCHED;
            } else {
            PG8_LDB(B0, 0, 0); PG8_SCHED; PG8_LDA(At, 0, 0); PG8_STAGE(PG8_SA(1, 1), a1 + hstep, voffA);
            PG8_WAIT_L(8); PG8_BAR; PG8_WAIT_L(0); PG8_MMA(0, 0, At, B0); PG8_BAR; PG8_SCHED;
            PG8_LDB(B1, 0, 1); PG8_STAGE(PG8_SB(0, 0), b2, voffB);
            PG8_BAR; PG8_WAIT_L(0); PG8_MMA(0, 1, At, B1); PG8_BAR;
            PG8_LDA(At, 0, 1); PG8_STAGE(PG8_SA(0, 0), a2, voffA);
            PG8_BAR; PG8_WAIT_L(0); PG8_MMA(1, 0, At, B0); PG8_BAR; PG8_SCHED;
            PG8_STAGE(PG8_SB(0, 1), b2 + hstep, voffB);
            PG8_WAIT_V(6); PG8_BAR; PG8_MMA(1, 1, At, B1); PG8_BAR;
            PG8_LDB(B0, 1, 0); PG8_SCHED; PG8_LDA(At, 1, 0); PG8_STAGE(PG8_SA(0, 1), a2 + hstep, voffA);
            PG8_WAIT_L(8); PG8_BAR; PG8_WAIT_L(0); PG8_MMA(0, 0, At, B0); PG8_BAR; PG8_SCHED;
            PG8_LDB(B1, 1, 1); PG8_STAGE(PG8_SB(1, 0), b3, voffB);
            PG8_BAR; PG8_WAIT_L(0); PG8_MMA(0, 1, At, B1); PG8_BAR;
            PG8_LDA(At, 1, 1); PG8_STAGE(PG8_SA(1, 0), a3, voffA);
            PG8_BAR; PG8_WAIT_L(0); PG8_MMA(1, 0, At, B0); PG8_BAR; PG8_SCHED;
            PG8_STAGE(PG8_SB(1, 1), b3 + hstep, voffB);
            PG8_WAIT_V(6); PG8_BAR; PG8_MMA(1, 1, At, B1); PG8_BAR;
            }
        }
        if constexpr (ALIGN_EPI) { if (wr == 0) PG8_BAR; }
        if constexpr (!Epi::AFTER_DRAIN) { E(acc, cur, wr, wc, fr, fq); S.done(cur); }
        if (!has_next) break;
#pragma unroll
        for (int a = 0; a < 2; ++a)
#pragma unroll
            for (int b = 0; b < 2; ++b)
#pragma unroll
                for (int m = 0; m < 4; ++m)
#pragma unroll
                    for (int n = 0; n < 2; ++n) { const float z0_ = opaque_zero(); acc[a][b][m][n] = (f32x4){z0_, z0_, z0_, z0_}; }
        cur = nxt; cA = nA; cB = nB; ++ui;
        if constexpr (ALIGN_EPI) { if (wr == 1) PG8_BAR; }
    }
    PG8_WAIT_V(0);
    if constexpr (!ALIGN_EPI) { if (wr == 0) PG8_BAR; }
    PG8_BAR;
    if constexpr (Epi::AFTER_DRAIN) { E.fused(acc, cur, wr, wc, fr, fq, lds, wid, lane); S.done(cur); }
#undef PG8_SA
#undef PG8_SB
#undef PG8_STAGE
#undef PG8_LDA
#undef PG8_LDB
#undef PG8_MMA
#undef PG8_WAIT_V
#undef PG8_WAIT_L
#undef PG8_BAR
#undef PG8_SCHED
}
}

#define LAS __attribute__((address_space(3)))
#define GAS __attribute__((address_space(1)))
typedef unsigned short bf16_t;
typedef short bf16x8 __attribute__((ext_vector_type(8)));
typedef float f32x4 __attribute__((ext_vector_type(4)));
typedef float f32x2 __attribute__((ext_vector_type(2)));
typedef float f32x16 __attribute__((ext_vector_type(16)));
typedef unsigned u32x4 __attribute__((ext_vector_type(4)));
typedef unsigned u32x2 __attribute__((ext_vector_type(2)));
typedef const GAS float* gcf;
typedef GAS float* gf;
typedef const GAS bf16_t* gcb;
typedef GAS bf16_t* gb;

constexpr int DM = 1024, SEQ = 4096, NB = 8, CTXL = 256, DFF = 2816;
constexpr int MLAT = NB * SEQ;
constexpr int MTOT = MLAT + NB * CTXL;
constexpr int NMODC = 9 * DM;
constexpr float EPS = 1e-6f;
constexpr float LOG2E = 1.4426950408889634f;
constexpr float LAM_INIT = 0.35550906759096934f;

constexpr size_t MiB = 1u << 20;
constexpr size_t WS_MODS = 0, WS_TAB = 2 * MiB, WS_BAR = 3 * MiB, BAR_ZERO_BYTES = 16384, WS_W0 = 4 * MiB, WS_WSZ = 44 * MiB, WS_X = 92 * MiB, WS_HN = 228 * MiB, WS_S = 296 * MiB, WS_END = 636 * MiB;
constexpr size_t S_HH = 0, S_PART = 192 * MiB;
constexpr size_t S_A = 0, S_CQN = 102 * MiB, S_CKVN = 128 * MiB, S_KR = 146 * MiB, S_Q = 152 * MiB, S_KN = 0, S_VT_MLA = 256 * MiB;
constexpr size_t S_QK = 0, S_VT_DIFF = 136 * MiB, S_O2 = 204 * MiB, S_VT_SWA = 88 * MiB;
constexpr size_t OFF_WIN0 = 0, OFF_WOUT0 = 5767168, OFF_WIN1 = 8650752, OFF_WOUT1 = 14417920, OFF_MIX = 17301504;
constexpr size_t MLA_WA = 0, MLA_WQB = 786432, MLA_WKN = 1376256, MLA_WVT = 1638400, MLA_WO = 1900544;
constexpr size_t DIF_WQK = 0, DIF_WV = 2097152, DIF_WO = 3145728;
constexpr size_t SWA_WQK = 0, SWA_WV = 1310720, SWA_WO = 1572864;

constexpr int LDS_BYTES = 147456;

__device__ const float INVF[16] = {1.0f, 0.5623413324356079f, 0.3162277638912201f, 0.17782793939113617f, 0.10000000149011612f, 0.05623413249850273f, 0.03162277489900589f, 0.017782794311642647f,
                                   0.009999999776482582f, 0.005623413249850273f, 0.003162277629598975f, 0.0017782794311642647f, 0.0010000000474974513f, 0.000562341301701963f, 0.0003162277571391314f, 0.00017782794020604342f};

enum { OP_PRO = 0, OP_NORM, OP_FFN_IN, OP_FFN_OUT, OP_MLA_IN, OP_MLA_ROW, OP_PROJ, OP_ATT, OP_DIFF_ROW, OP_MIX_OUT, OP_FINAL };
#ifndef DUP_MASK
#define DUP_MASK 0
#endif
#ifndef DUP_SYNC
#define DUP_SYNC 0
#endif
#ifndef PROBE_SKIP_EPI
#define PROBE_SKIP_EPI 0
#endif
struct Prog { unsigned e[128]; int n; };
constexpr void prog_add(Prog& p, int op, int l, int s) {
    p.e[p.n++] = (unsigned)op | ((unsigned)l << 8) | ((unsigned)s << 16);
    if ((DUP_MASK >> op) & 1) p.e[p.n++] = (unsigned)op | ((unsigned)l << 8) | ((unsigned)(s | 0x80) << 16);
}
constexpr Prog make_prog() {
    Prog p{}; p.n = 0;
    prog_add(p, OP_PRO, 0, 0);
    for (int l = 0; l < 4; ++l) {
        const int kind = l % 3;
        prog_add(p, OP_NORM, l, 0); prog_add(p, OP_FFN_IN, l, 0); prog_add(p, OP_FFN_OUT, l, 0); prog_add(p, OP_NORM, l, 1);
        if (kind == 0) { prog_add(p, OP_MLA_IN, l, 0); prog_add(p, OP_MLA_ROW, l, 0); }
        prog_add(p, OP_PROJ, l, 0); prog_add(p, OP_ATT, l, 0);
        if (kind == 1) prog_add(p, OP_DIFF_ROW, l, 0);
        prog_add(p, OP_MIX_OUT, l, 0); prog_add(p, OP_NORM, l, 2); prog_add(p, OP_FFN_IN, l, 1); prog_add(p, OP_FFN_OUT, l, 1);
    }
    prog_add(p, OP_FINAL, 0, 0);
    return p;
}
constexpr Prog PROG_H = make_prog();
constexpr int NPHASE = PROG_H.n;
__device__ const Prog PROG_D = make_prog();

__device__ __forceinline__ unsigned pk2(float lo, float hi) { typedef __bf16 bf16x2_t __attribute__((ext_vector_type(2))); f32x2 v = {lo, hi}; bf16x2_t b = __builtin_convertvector(v, bf16x2_t); return __builtin_bit_cast(unsigned, b); }
__device__ __forceinline__ float wave_sum_l(float v, int lane) {
#pragma unroll
    for (int o = 1; o < 64; o <<= 1) v += __int_as_float(__builtin_amdgcn_ds_bpermute((lane ^ o) << 2, __float_as_int(v)));
    return v;
}
#define wave_sum(v) wave_sum_l((v), lane)
__device__ __forceinline__ float fast_exp2(float x) { return __builtin_amdgcn_exp2f(x); }
__device__ __forceinline__ float silu_fast(float x) { return x * __builtin_amdgcn_rcpf(1.0f + __builtin_amdgcn_exp2f(-x * LOG2E)); }
__device__ __forceinline__ float half_max(float m) { auto rr = __builtin_amdgcn_permlane32_swap(__float_as_uint(m), __float_as_uint(m), false, false); return fmaxf(__uint_as_float(rr[0]), __uint_as_float(rr[1])); }
__device__ __forceinline__ float half_sum(float m) { auto rr = __builtin_amdgcn_permlane32_swap(__float_as_uint(m), __float_as_uint(m), false, false); return __uint_as_float(rr[0]) + __uint_as_float(rr[1]); }

struct EpiStoreBf16 {
    static constexpr bool PERM = true, AFTER_DRAIN = false;
    gb O; int ldc;
    __device__ __forceinline__ void operator()(const f32x4 (&acc)[2][2][4][2], const pg8::Unit& u, int wr, int wc, int fr, int fq) const {
        const int row0 = u.pm * 256 + wr * 64 + fr, col0 = u.pn * 256 + wc * 32 + 8 * fq;
#pragma unroll
        for (int ai = 0; ai < 2; ++ai)
#pragma unroll
            for (int m = 0; m < 4; ++m) { gb rowp = O + (size_t)(row0 + ai * 128 + m * 16) * ldc + col0;
#pragma unroll
                for (int bj = 0; bj < 2; ++bj) { const f32x4 v0 = acc[ai][bj][m][0], v1 = acc[ai][bj][m][1];
                    u32x4 w; w.x = pk2(v0[0], v0[1]); w.y = pk2(v0[2], v0[3]); w.z = pk2(v1[0], v1[1]); w.w = pk2(v1[2], v1[3]);
                    *(GAS u32x4*)(rowp + bj * 128) = w; } }
    }
};
struct EpiSwiglu {
    static constexpr bool PERM = true, AFTER_DRAIN = false;
    gb O;
    __device__ __forceinline__ void operator()(const f32x4 (&acc)[2][2][4][2], const pg8::Unit& u, int wr, int wc, int fr, int fq) const {
        const int row0 = u.pm * 256 + wr * 64 + fr, col0 = u.pn * 128 + wc * 32 + 8 * fq;
#pragma unroll
        for (int ai = 0; ai < 2; ++ai)
#pragma unroll
            for (int m = 0; m < 4; ++m) { gb rowp = O + (size_t)(row0 + ai * 128 + m * 16) * DFF + col0;
                const f32x4 g0 = acc[ai][0][m][0], g1 = acc[ai][0][m][1], u0 = acc[ai][1][m][0], u1 = acc[ai][1][m][1];
                u32x4 w; w.x = pk2(silu_fast(g0[0]) * u0[0], silu_fast(g0[1]) * u0[1]); w.y = pk2(silu_fast(g0[2]) * u0[2], silu_fast(g0[3]) * u0[3]);
                w.z = pk2(silu_fast(g1[0]) * u1[0], silu_fast(g1[1]) * u1[1]); w.w = pk2(silu_fast(g1[2]) * u1[2], silu_fast(g1[3]) * u1[3]);
                *(GAS u32x4*)rowp = w; }
    }
};
struct EpiResid {
    static constexpr bool PERM = true, AFTER_DRAIN = false;
    gcf base_lat, base_ctx; gf X; gcf gate; unsigned gsc_bits;
    __device__ __forceinline__ void operator()(const f32x4 (&acc)[2][2][4][2], const pg8::Unit& u, int wr, int wc, int fr, int fq) const {
        if (PROBE_SKIP_EPI && gsc_bits == 0u) return;
        const int b = u.pm < 128 ? (u.pm >> 4) : 8;
        const int col0 = u.pn * 256 + wc * 32 + 8 * fq;
        gcf gp = gate + (size_t)b * NMODC + col0;
        f32x4 gv[2][2];
#pragma unroll
        for (int bj = 0; bj < 2; ++bj)
#pragma unroll
            for (int n = 0; n < 2; ++n) gv[bj][n] = *(const GAS f32x4*)(gp + bj * 128 + n * 4) * __uint_as_float(gsc_bits);
#pragma unroll
        for (int ai = 0; ai < 2; ++ai)
#pragma unroll
            for (int m = 0; m < 4; ++m) { const int row = u.pm * 256 + ai * 128 + wr * 64 + m * 16 + fr;
                gcf bp = (row < MLAT ? base_lat + (size_t)row * DM : base_ctx + (size_t)(row - MLAT) * DM) + col0;
                gf xp = X + (size_t)row * DM + col0;
#pragma unroll
                for (int bj = 0; bj < 2; ++bj)
#pragma unroll
                    for (int n = 0; n < 2; ++n) {
                        if (u.split) { gf part = (gf)((GAS unsigned char*)X + (WS_S + S_PART - WS_X)); *(GAS f32x4*)(part + ((size_t)(u.split - 1) * 2048 + (row - MLAT)) * DM + col0 + bj * 128 + n * 4) = acc[ai][bj][m][n]; }
                        else { const f32x4 bs = *(const GAS f32x4*)(bp + bj * 128 + n * 4); *(GAS f32x4*)(xp + bj * 128 + n * 4) = bs + gv[bj][n] * acc[ai][bj][m][n]; } } }
    }
};
struct EpiF32 {
    static constexpr bool PERM = false, AFTER_DRAIN = false;
    gf O; int ldc;
    __device__ __forceinline__ void operator()(const f32x4 (&acc)[2][2][4][2], const pg8::Unit& u, int wr, int wc, int fr, int fq) const {
        const int col0 = u.pn * 256 + wc * 32 + 4 * fq;
#pragma unroll
        for (int ai = 0; ai < 2; ++ai)
#pragma unroll
            for (int m = 0; m < 4; ++m) { gf op = O + (size_t)(u.pm * 256 + ai * 128 + wr * 64 + m * 16 + fr) * ldc + col0;
#pragma unroll
                for (int bj = 0; bj < 2; ++bj)
#pragma unroll
                    for (int n = 0; n < 2; ++n) *(GAS f32x4*)(op + bj * 128 + n * 16) = acc[ai][bj][m][n]; }
    }
};
struct EpiRope {
    static constexpr bool PERM = false, AFTER_DRAIN = false;
    gb O; int ldc, period, rope_start, nq; float qscale; gcf tab;
    __device__ __forceinline__ void operator()(const f32x4 (&acc)[2][2][4][2], const pg8::Unit& u, int wr, int wc, int fr, int fq) const {
        const bool lat = u.pm < 128;
#pragma unroll
        for (int bj = 0; bj < 2; ++bj) {
            const int colg = u.pn * 256 + bj * 128 + wc * 32, cm = colg % period;
            const bool rope = lat && (cm >= rope_start);
            const int axis = ((cm - rope_start) >> 5) & 1;
            const float sc = colg < nq ? qscale : 1.0f;
#pragma unroll
            for (int ai = 0; ai < 2; ++ai)
#pragma unroll
                for (int m = 0; m < 4; ++m) { const int row = u.pm * 256 + ai * 128 + wr * 64 + m * 16 + fr;
                    f32x4 x1 = acc[ai][bj][m][0], x2 = acc[ai][bj][m][1];
                    if (rope) { const int t = row & (SEQ - 1), pos = axis ? (t & 63) : (t >> 6);
                        const GAS f32x4* tp = (const GAS f32x4*)(tab + (pos * 16 + 4 * fq) * 2);
                        const f32x4 t0 = tp[0], t1 = tp[1];
                        const f32x4 c = {t0[0], t0[2], t1[0], t1[2]}, s = {t0[1], t0[3], t1[1], t1[3]};
                        const f32x4 o1 = x1 * c - x2 * s, o2 = x2 * c + x1 * s; x1 = o1; x2 = o2; }
                    x1 = x1 * sc; x2 = x2 * sc;
                    const unsigned a0 = pk2(x1[0], x1[1]), a1 = pk2(x1[2], x1[3]), b0 = pk2(x2[0], x2[1]), b1 = pk2(x2[2], x2[3]);
                    const auto r0 = __builtin_amdgcn_permlane16_swap(a0, b0, false, false), r1 = __builtin_amdgcn_permlane16_swap(a1, b1, false, false);
                    u32x4 w; w.x = r0[0]; w.y = r1[0]; w.z = r0[1]; w.w = r1[1];
                    gb op = O + (size_t)row * ldc + colg + ((fq & 1) ? 16 + 4 * (fq - 1) : 4 * fq);
                    *(GAS u32x4*)op = w;
                    asm volatile("" ::: "memory"); }
        }
    }
};

template <class Epi> __device__ __forceinline__ void run_gemm(LAS unsigned char* lds, int G_, int bx_, gcb A, gcb Bt, int M, int N, int K, const Epi& E, bool split = false) {
    pg8::Gemm g{(const bf16_t*)A, (const bf16_t*)Bt, M, N, K}; pg8::StaticOrder S; S.init(M, N, G_, bx_, K / 64, split);
    pg8::gemm_phase<Epi, pg8::StaticOrder, true, true>(lds, g, S, E);
}

__device__ __forceinline__ unsigned f2bf(float f) { unsigned u = __builtin_bit_cast(unsigned, f); return (u + 0x7fffu + ((u >> 16) & 1u)) >> 16; }
__device__ __forceinline__ unsigned pk2s(float lo, float hi) { return f2bf(lo) | (f2bf(hi) << 16); }
__device__ __forceinline__ void conv_item(gcf W, int K, int N, int k0, int n0, gb drow, LAS float* scr, int lane) {
#pragma unroll 8
    for (int i = 0; i < 32; ++i) { const int kk = 2 * i + (lane >> 5); scr[kk * 33 + (lane & 31)] = W[(size_t)(k0 + kk) * N + n0 + (lane & 31)]; }
    asm volatile("s_waitcnt lgkmcnt(0)" ::: "memory");
    const int c = lane & 7;
#pragma unroll
    for (int j = 0; j < 4; ++j) { const int n = (lane >> 3) + 8 * j; const LAS float* s = scr + (8 * c) * 33 + n;
        u32x4 o; o.x = pk2s(s[0 * 33], s[1 * 33]); o.y = pk2s(s[2 * 33], s[3 * 33]); o.z = pk2s(s[4 * 33], s[5 * 33]); o.w = pk2s(s[6 * 33], s[7 * 33]);
        *(GAS u32x4*)(drow + (size_t)n * K + k0 + 8 * c) = o; }
    asm volatile("s_waitcnt lgkmcnt(0)" ::: "memory");
}
__device__ __forceinline__ bool conv_job(int& r, gcf W, int K, int N, int kind, gb d1, gb d2, int S, LAS float* scr, int lane) {
    const int nblk = N / 32, items = (K / 64) * nblk;
    if (r >= items) { r -= items; return false; }
    const int kb = r / nblk, nb = r % nblk, k0 = 64 * kb, n0 = 32 * nb;
    gb drow;
    if (kind == 0) drow = d1 + (size_t)n0 * K;
    else if (kind == 1) { const int nn = n0 < DFF ? n0 : n0 - DFF; drow = d1 + (size_t)(256 * (nn / 128) + (n0 < DFF ? 0 : 128) + (nn % 128)) * K; }
    else if (kind == 2) drow = n0 < S ? d1 + (size_t)n0 * K : d2 + (size_t)(n0 - S) * K;
    else { const int h = n0 / 256, off = n0 % 256; drow = off < 128 ? d1 + (size_t)(h * 128 + off) * K : d2 + (size_t)(h * 128 + off - 128) * K; }
    conv_item(W, K, N, k0, n0, drow, scr, lane);
    return true;
}

struct Ptrs {
    gcf x, c, ctx, c_ctx, w_mod, b_mod, g_norm, w_ffn_in, w_ffn_out, a_w_in, a_g_q, a_g_kv, a_w_qb, a_w_kvb, a_w_o, b_w_qkv, b_lambda, b_g_sub, b_w_o, c_w_qkv, c_sink, c_w_o, g_final;
    gf out; GAS unsigned char* ws; int bx, G;
};

__device__ __forceinline__ void conv_layer(const Ptrs& P, int l, LAS unsigned char* lds, int tid, int wid, int lane) {
    gb Wd = (gb)(P.ws + WS_W0 + (size_t)(l & 1) * WS_WSZ);
    LAS float* scr = (LAS float*)(lds + wid * 16384);
    const int gw = P.bx * 8 + wid, NGW = P.G * 8;
    const int kind = l % 3, j = l / 3;
    gcf fin0 = P.w_ffn_in + (size_t)(l * 2 + 0) * DM * 2 * DFF, fin1 = P.w_ffn_in + (size_t)(l * 2 + 1) * DM * 2 * DFF;
    gcf fo0 = P.w_ffn_out + (size_t)(l * 2 + 0) * DFF * DM, fo1 = P.w_ffn_out + (size_t)(l * 2 + 1) * DFF * DM;
    gb mix = Wd + OFF_MIX;
    for (int it = gw; it < 16384; it += NGW) {
        int r = it;
        if (conv_job(r, fin0, DM, 2 * DFF, 1, Wd + OFF_WIN0, Wd, 0, scr, lane)) continue;
        if (conv_job(r, fo0, DFF, DM, 0, Wd + OFF_WOUT0, Wd, 0, scr, lane)) continue;
        if (conv_job(r, fin1, DM, 2 * DFF, 1, Wd + OFF_WIN1, Wd, 0, scr, lane)) continue;
        if (conv_job(r, fo1, DFF, DM, 0, Wd + OFF_WOUT1, Wd, 0, scr, lane)) continue;
        if (kind == 0) {
            if (conv_job(r, P.a_w_in + (size_t)j * DM * 704, DM, 704, 0, mix + MLA_WA, mix, 0, scr, lane)) continue;
            if (conv_job(r, P.a_w_qb + (size_t)j * 384 * 1536, 384, 1536, 0, mix + MLA_WQB, mix, 0, scr, lane)) continue;
            if (conv_job(r, P.a_w_kvb + (size_t)j * 256 * 2048, 256, 2048, 3, mix + MLA_WKN, mix + MLA_WVT, 0, scr, lane)) continue;
            if (conv_job(r, P.a_w_o + (size_t)j * DM * DM, DM, DM, 0, mix + MLA_WO, mix, 0, scr, lane)) continue;
        } else if (kind == 1) {
            if (conv_job(r, P.b_w_qkv, DM, 3072, 2, mix + DIF_WQK, mix + DIF_WV, 2048, scr, lane)) continue;
            if (conv_job(r, P.b_w_o, DM, DM, 0, mix + DIF_WO, mix, 0, scr, lane)) continue;
        } else {
            if (conv_job(r, P.c_w_qkv, DM, 1536, 2, mix + SWA_WQK, mix + SWA_WV, 1280, scr, lane)) continue;
            if (conv_job(r, P.c_w_o, DM, DM, 0, mix + SWA_WO, mix, 0, scr, lane)) continue;
        }
        break;
    }
    if (kind == 0) {
        const int gt = P.bx * 512 + tid, NT = P.G * 512;
        for (int i = gt; i < 8192; i += NT) { const unsigned zz = __float_as_uint(opaque_zero()); *(GAS u32x4*)(mix + MLA_WA + (size_t)704 * DM + (size_t)i * 8) = (u32x4){zz, zz, zz, zz}; }
    }
}

__device__ __forceinline__ void sincos_d(double a, float& c, float& s) {
    const double TWO_PI = 6.283185307179586476925286766559;
    const double k = __builtin_rint(a / TWO_PI); const double r = a - k * TWO_PI, r2 = r * r;
    double ts = r, ss = r, tc = 1.0, cc = 1.0;
#pragma unroll
    for (int i = 1; i <= 14; ++i) { tc *= -r2 / (double)((2 * i - 1) * (2 * i)); cc += tc; ts *= -r2 / (double)((2 * i) * (2 * i + 1)); ss += ts; }
    c = (float)cc; s = (float)ss;
}
__device__ __forceinline__ void prologue(const Ptrs& P, LAS unsigned char* lds, int tid, int wid, int lane) {
    if (P.bx == 0) {
        gf tab = (gf)(P.ws + WS_TAB);
        for (int idx = tid; idx < 1024; idx += 512) { const int pos = idx >> 4, i = idx & 15; const float ang = (float)pos * INVF[i]; float c, s; sincos_d((double)ang, c, s); tab[idx * 2] = c; tab[idx * 2 + 1] = s; }
    }
    LAS float* sS = (LAS float*)lds;
    LAS float* red = (LAS float*)(lds + 49152);
    for (int idx = tid; idx < 9 * DM; idx += 512) { const int b = idx >> 10, k = idx & 1023; const float v = b < 8 ? P.c[b * DM + k] : P.c_ctx[k]; sS[k * 12 + b] = v / (1.0f + __expf(-v)); }
    __syncthreads();
    gf mods = (gf)(P.ws + WS_MODS);
    for (int u = P.bx; u < 4 * 72; u += P.G) {
        const int l = u / 72, n0 = (u % 72) * 128;
        gcf wp = P.w_mod + ((size_t)l * DM + wid * 128) * NMODC + n0 + 2 * lane;
        float acc[9][2];
#pragma unroll
        for (int b = 0; b < 9; ++b) { acc[b][0] = 0.f; acc[b][1] = 0.f; }
#pragma unroll 8
        for (int k = 0; k < 128; ++k) {
            const f32x2 w = *(const GAS f32x2*)(wp + (size_t)k * NMODC);
            const LAS f32x4* sp = (const LAS f32x4*)(sS + (wid * 128 + k) * 12);
            const f32x4 s0 = sp[0], s1 = sp[1], s2 = sp[2];
            acc[0][0] += s0[0] * w[0]; acc[0][1] += s0[0] * w[1]; acc[1][0] += s0[1] * w[0]; acc[1][1] += s0[1] * w[1];
            acc[2][0] += s0[2] * w[0]; acc[2][1] += s0[2] * w[1]; acc[3][0] += s0[3] * w[0]; acc[3][1] += s0[3] * w[1];
            acc[4][0] += s1[0] * w[0]; acc[4][1] += s1[0] * w[1]; acc[5][0] += s1[1] * w[0]; acc[5][1] += s1[1] * w[1];
            acc[6][0] += s1[2] * w[0]; acc[6][1] += s1[2] * w[1]; acc[7][0] += s1[3] * w[0]; acc[7][1] += s1[3] * w[1];
            acc[8][0] += s2[0] * w[0]; acc[8][1] += s2[0] * w[1];
        }
#pragma unroll
        for (int b = 0; b < 9; ++b) { red[(wid * 9 + b) * 128 + 2 * lane] = acc[b][0]; red[(wid * 9 + b) * 128 + 2 * lane + 1] = acc[b][1]; }
        __syncthreads();
        for (int idx = tid; idx < 9 * 128; idx += 512) { const int b = idx >> 7, n = idx & 127; float s = 0.f;
#pragma unroll
            for (int w = 0; w < 8; ++w) s += red[(w * 9 + b) * 128 + n];
            mods[((size_t)l * 9 + b) * NMODC + n0 + n] = s + P.b_mod[(size_t)l * NMODC + n0 + n]; }
        __syncthreads();
    }
    __syncthreads();
    conv_layer(P, 0, lds, tid, wid, lane);
}

__device__ __forceinline__ void norm_phase(const Ptrs& P, int l, int which, int wid, int lane) {
    const bool from_in = (l == 0 && which == 0);
    gcf X = (gcf)(P.ws + WS_X);
    gcf slat = from_in ? P.x : X, sctx = from_in ? P.ctx : X + (size_t)MLAT * DM;
    gb Hn = (gb)(P.ws + WS_HN);
    gcf g = P.g_norm + (size_t)(l * 3 + which) * DM;
    gcf mods = (gcf)(P.ws + WS_MODS) + (size_t)l * 9 * NMODC + (size_t)(3 * which) * DM;
    const int M = (l == 3 && which == 2) ? MLAT : MTOT;
    const int gw = P.bx * 8 + wid, NGW = P.G * 8;
    const bool pend = !from_in && which != 2;
    const int pl = which == 0 ? l - 1 : l, pidx = which == 0 ? 8 : (which == 1 ? 2 : 5);
    const float pgsc = which == 2 ? 1.0f : 0.5f;
    gcf pgate = (gcf)(P.ws + WS_MODS) + ((size_t)(pend ? pl : 0) * 9 + 8) * NMODC + (size_t)pidx * DM;
    gcf part = (gcf)(P.ws + WS_S + S_PART);
    f32x4 gg[4];
#pragma unroll
    for (int j = 0; j < 4; ++j) gg[j] = ((const GAS f32x4*)g)[lane + 64 * j];
    f32x4 vn[4];
#define NORM_XR(r) ((const GAS f32x4*)((r) < MLAT ? slat + (size_t)(r) * DM : sctx + (size_t)((r) - MLAT) * DM) + lane)
    if (gw < M) { const GAS f32x4* xr0 = NORM_XR(gw);
#pragma unroll
        for (int j = 0; j < 4; ++j) vn[j] = xr0[64 * j]; }
    int bcur = -1; f32x4 shv[4], scv[4];
#pragma unroll
    for (int j = 0; j < 4; ++j) { shv[j] = (f32x4){0.f, 0.f, 0.f, 0.f}; scv[j] = (f32x4){0.f, 0.f, 0.f, 0.f}; }
    for (int row = gw; row < M; row += NGW) {
        const int b = row < MLAT ? (row >> 12) : 8;
        if (b != bcur) { bcur = b;
#pragma unroll
            for (int j = 0; j < 4; ++j) { shv[j] = ((const GAS f32x4*)(mods + (size_t)b * NMODC))[lane + 64 * j]; scv[j] = ((const GAS f32x4*)(mods + (size_t)b * NMODC + DM))[lane + 64 * j] + 1.0f; } }
        f32x4 v[4]; float s = 0.f;
#pragma unroll
        for (int j = 0; j < 4; ++j) v[j] = vn[j];
        if (row + NGW < M) { const GAS f32x4* xr1 = NORM_XR(row + NGW);
#pragma unroll
            for (int j = 0; j < 4; ++j) vn[j] = xr1[64 * j]; }
#pragma unroll
        for (int j = 0; j < 4; ++j) s += (v[j][0] * v[j][0] + v[j][1] * v[j][1]) + (v[j][2] * v[j][2] + v[j][3] * v[j][3]);
        if (from_in) { GAS f32x4* xo = (GAS f32x4*)(P.ws + WS_X + (size_t)row * DM * 4) + lane;
#pragma unroll
            for (int j = 0; j < 4; ++j) xo[64 * j] = v[j]; }
        else if (pend && row >= MLAT) { GAS f32x4* xo = (GAS f32x4*)(P.ws + WS_X + (size_t)row * DM * 4) + lane; s = 0.f;
#pragma unroll
            for (int j = 0; j < 4; ++j) { f32x4 a = {0.f, 0.f, 0.f, 0.f};
#pragma unroll
                for (int p = 0; p < 8; ++p) a += ((const GAS f32x4*)(part + ((size_t)p * 2048 + (row - MLAT)) * DM))[lane + 64 * j];
                v[j] = v[j] + (((const GAS f32x4*)pgate)[lane + 64 * j] * pgsc) * a; xo[64 * j] = v[j];
                s += (v[j][0] * v[j][0] + v[j][1] * v[j][1]) + (v[j][2] * v[j][2] + v[j][3] * v[j][3]); } }
        const float rstd = 1.0f / sqrtf(wave_sum(s) * (1.0f / DM) + EPS);
        GAS u32x2* o8 = (GAS u32x2*)(Hn + (size_t)row * DM) + lane;
#pragma unroll
        for (int j = 0; j < 4; ++j) { const f32x4 hv = (v[j] * rstd) * gg[j] * scv[j] + shv[j];
            u32x2 w; w.x = pk2(hv[0], hv[1]); w.y = pk2(hv[2], hv[3]); o8[64 * j] = w; }
    }
#undef NORM_XR
}
__device__ __forceinline__ void mla_row_phase(const Ptrs& P, int l, int wid, int lane) {
    const int j = l / 3;
    gcf A = (gcf)(P.ws + WS_S + S_A); gb cqn = (gb)(P.ws + WS_S + S_CQN), ckvn = (gb)(P.ws + WS_S + S_CKVN), kr = (gb)(P.ws + WS_S + S_KR);
    gcf gq = P.a_g_q + (size_t)j * 384, gkv = P.a_g_kv + (size_t)j * 256; gcf tab = (gcf)(P.ws + WS_TAB);
    const int gw = P.bx * 8 + wid, NGW = P.G * 8;
    const bool qlane = lane < 48;
    f32x4 gq0 = {0.f, 0.f, 0.f, 0.f}, gq1 = {0.f, 0.f, 0.f, 0.f};
    if (qlane) { gq0 = *(const GAS f32x4*)(gq + 8 * lane); gq1 = *(const GAS f32x4*)(gq + 8 * lane + 4); }
    const f32x4 g4 = *(const GAS f32x4*)(gkv + 4 * lane);
    for (int row = gw; row < MTOT; row += NGW) {
        gcf a = A + (size_t)row * 768;
        f32x4 q0 = {0.f, 0.f, 0.f, 0.f}, q1 = {0.f, 0.f, 0.f, 0.f};
        if (qlane) { q0 = *(const GAS f32x4*)(a + 8 * lane); q1 = *(const GAS f32x4*)(a + 8 * lane + 4); }
        const f32x4 kv = *(const GAS f32x4*)(a + 384 + 4 * lane);
        const float s = ((q0[0] * q0[0] + q0[1] * q0[1]) + (q0[2] * q0[2] + q0[3] * q0[3])) + ((q1[0] * q1[0] + q1[1] * q1[1]) + (q1[2] * q1[2] + q1[3] * q1[3]));
        const float rq = 1.0f / sqrtf(wave_sum(s) * (1.0f / 384.0f) + EPS);
        if (qlane) { u32x4 w; w.x = pk2(q0[0] * rq * gq0[0], q0[1] * rq * gq0[1]); w.y = pk2(q0[2] * rq * gq0[2], q0[3] * rq * gq0[3]); w.z = pk2(q1[0] * rq * gq1[0], q1[1] * rq * gq1[1]); w.w = pk2(q1[2] * rq * gq1[2], q1[3] * rq * gq1[3]);
            *(GAS u32x4*)(cqn + (size_t)row * 384 + 8 * lane) = w; }
        const float rk = 1.0f / sqrtf(wave_sum((kv[0] * kv[0] + kv[1] * kv[1]) + (kv[2] * kv[2] + kv[3] * kv[3])) * (1.0f / 256.0f) + EPS);
        { u32x2 w; w.x = pk2(kv[0] * rk * g4[0], kv[1] * rk * g4[1]); w.y = pk2(kv[2] * rk * g4[2], kv[3] * rk * g4[3]); *(GAS u32x2*)(ckvn + (size_t)row * 256 + 4 * lane) = w; }
        const float mine = a[640 + lane]; const float other = __int_as_float(__builtin_amdgcn_ds_bpermute((lane ^ 16) << 2, __float_as_int(mine)));
        float outv = mine;
        if (row < MLAT) { const int t = row & (SEQ - 1), axis = lane >> 5, pos = axis ? (t & 63) : (t >> 6), i = lane & 15;
            const float c = tab[(pos * 16 + i) * 2], sn = tab[(pos * 16 + i) * 2 + 1];
            outv = (lane & 16) ? (mine * c + other * sn) : (mine * c - other * sn); }
        kr[(size_t)row * 64 + lane] = (bf16_t)f2bf(outv);
    }
}
__device__ __forceinline__ void diff_row_phase(const Ptrs& P, int wid, int lane) {
    gcb O2 = (gcb)(P.ws + WS_S + S_O2); gb On = (gb)(P.ws + WS_HN);
    gcf lp = P.b_lambda;
    const float lam = __expf(wave_sum(lp[lane] * lp[64 + lane])) - __expf(wave_sum(lp[128 + lane] * lp[192 + lane])) + LAM_INIT;
    const int sub = lane & 15, hq = lane >> 4;
    const f32x4 ga = *(const GAS f32x4*)(P.b_g_sub + 8 * sub), gb4 = *(const GAS f32x4*)(P.b_g_sub + 8 * sub + 4);
    const int gw = P.bx * 8 + wid, NGW = P.G * 8;
    for (int row = gw; row < MTOT; row += NGW) {
#pragma unroll
        for (int it = 0; it < 2; ++it) { const int h = hq + 4 * it;
            const u32x4 av = *(const GAS u32x4*)(O2 + (size_t)row * 2048 + (2 * h) * 128 + 8 * sub), bv = *(const GAS u32x4*)(O2 + (size_t)row * 2048 + (2 * h + 1) * 128 + 8 * sub);
            float d[8]; float ss = 0.f;
#pragma unroll
            for (int e = 0; e < 4; ++e) { d[2 * e] = __uint_as_float(av[e] << 16) - lam * __uint_as_float(bv[e] << 16); d[2 * e + 1] = __uint_as_float(av[e] & 0xffff0000u) - lam * __uint_as_float(bv[e] & 0xffff0000u);
                ss += d[2 * e] * d[2 * e] + d[2 * e + 1] * d[2 * e + 1]; }
#pragma unroll
            for (int o = 1; o < 16; o <<= 1) ss += __int_as_float(__builtin_amdgcn_ds_bpermute((lane ^ o) << 2, __float_as_int(ss)));
            const float r = 1.0f / sqrtf(ss * (1.0f / 128.0f) + EPS) * (1.0f - LAM_INIT);
            u32x4 w; w.x = pk2(d[0] * r * ga[0], d[1] * r * ga[1]); w.y = pk2(d[2] * r * ga[2], d[3] * r * ga[3]); w.z = pk2(d[4] * r * gb4[0], d[5] * r * gb4[1]); w.w = pk2(d[6] * r * gb4[2], d[7] * r * gb4[3]);
            *(GAS u32x4*)(On + (size_t)row * DM + h * 128 + 8 * sub) = w;
        }
    }
}
__device__ __forceinline__ void final_phase(const Ptrs& P, int wid, int lane) {
    gcf X = (gcf)(P.ws + WS_X);
    const int gw = P.bx * 8 + wid, NGW = P.G * 8;
    f32x4 gg[4];
#pragma unroll
    for (int j = 0; j < 4; ++j) gg[j] = ((const GAS f32x4*)P.g_final)[lane + 64 * j];
    f32x4 vn[4];
    if (gw < MLAT) { const GAS f32x4* xr0 = (const GAS f32x4*)(X + (size_t)gw * DM) + lane;
#pragma unroll
        for (int j = 0; j < 4; ++j) vn[j] = xr0[64 * j]; }
    for (int row = gw; row < MLAT; row += NGW) {
        f32x4 v[4]; float s = 0.f;
#pragma unroll
        for (int j = 0; j < 4; ++j) v[j] = vn[j];
        if (row + NGW < MLAT) { const GAS f32x4* xr1 = (const GAS f32x4*)(X + (size_t)(row + NGW) * DM) + lane;
#pragma unroll
            for (int j = 0; j < 4; ++j) vn[j] = xr1[64 * j]; }
#pragma unroll
        for (int j = 0; j < 4; ++j) s += (v[j][0] * v[j][0] + v[j][1] * v[j][1]) + (v[j][2] * v[j][2] + v[j][3] * v[j][3]);
        const float rstd = 1.0f / sqrtf(wave_sum(s) * (1.0f / DM) + EPS);
        GAS f32x4* op = (GAS f32x4*)(P.out + (size_t)row * DM) + lane;
#pragma unroll
        for (int j = 0; j < 4; ++j) op[64 * j] = (v[j] * rstd) * gg[j];
    }
}

template <int DQK, int DV, bool MLA, bool WINDOW, bool SINK>
__device__ __forceinline__ void attn_phase(LAS unsigned char* lds, gcb Q, int ldq, gcb K, int ldk, gcb Kr, gcb Vt, gb O, int ldo, int nheads, int kdiv, int vdiv, gcf sink, bool with_ctx_q, int vcu, int G) {
    constexpr int KCH = DQK / 8, KCHP = KCH + 1, KSTR = KCHP * 16, VCHP = 9, VSTR = VCHP * 16, KBUF = 64 * KSTR, VBUF = DV * VSTR;
    constexpr int KINST = KCHP, VINST = (DV * VCHP) / 64;
    constexpr int NDC = DQK / 16, NDVB = DV / 32, NKI = (KINST + 7) / 8, NVI = (VINST + 7) / 8;
    constexpr int NDMA = KINST / 8 + VINST / 8;
    LAS unsigned char* ldsK = lds; LAS unsigned char* ldsV = lds + 3 * KBUF;
    static_assert(3 * (KBUF + VBUF) <= 140 * 1024, "attention LDS ring");
    int tid_ = threadIdx.x; asm volatile("" : "+v"(tid_));
    const int tid = tid_, lane = tid & 63, r32 = lane & 31, hi = lane >> 5, wid = __builtin_amdgcn_readfirstlane(tid >> 6);
    const int nlat = NB * nheads * 16, nunits = nlat + (with_ctx_q ? NB * nheads : 0);
    const int pr = (r32 & 0x13) | ((r32 & 4) << 1) | ((r32 & 8) >> 1);
    int kc[NKI], ks[NKI], kh[NKI], vc[NVI];
#pragma unroll
    for (int i = 0; i < NKI; ++i) { const int q = (wid + 8 * i) * 64 + lane, row = q / KCHP, cp = q % KCHP, c = cp < KCH ? cp : 0;
        if (MLA) { if (c < 16) { kc[i] = row * 2048 + c * 16; ks[i] = 2048; kh[i] = 2; } else { kc[i] = (int)((const GAS unsigned char*)Kr - (const GAS unsigned char*)K) + row * 128 + (c - 16) * 16; ks[i] = 128; kh[i] = 0; } }
        else { kc[i] = row * ldk * 2 + c * 16; ks[i] = ldk * 2; kh[i] = 2; } }
#pragma unroll
    for (int i = 0; i < NVI; ++i) { const int q = (wid + 8 * i) * 64 + lane, dv = q / VCHP, cp = q % VCHP, c = cp < 8 ? cp : 0; vc[i] = dv * (MTOT * 2) + c * 16; }
    for (int u = vcu; u < nunits; u += G) {
        int bh, qblk; if (u < nlat) { bh = u >> 4; qblk = u & 15; } else { bh = u - nlat; qblk = 16; }
        const int head = bh % nheads, b = bh / nheads;
        const bool isctx = (qblk == 16);
        const int qrow0 = isctx ? MLAT + b * CTXL : b * SEQ + qblk * 256;
        int lt0 = 0, lt1 = isctx ? 0 : 64;
        if (WINDOW && !isctx) { int lo = qblk * 256 - 128; if (lo < 0) lo = 0; int hh = qblk * 256 + 384; if (hh > SEQ) hh = SEQ; lt0 = lo >> 6; lt1 = hh >> 6; }
        const int NT = 4 + (lt1 - lt0);
        const int kcol = (head / kdiv) * (MLA ? 128 : 64);
        const size_t vrow0 = (size_t)(head / vdiv) * DV;
        bf16x8 qf[NDC];
        { gcb qp = Q + (size_t)(qrow0 + wid * 32 + r32) * ldq + head * DQK + hi * 8;
#pragma unroll
          for (int dc = 0; dc < NDC; ++dc) qf[dc] = *(const GAS bf16x8*)(qp + dc * 16); }
        float m_run = -1e30f, l_run = 0.f;
        if (SINK) { m_run = sink[head] * LOG2E; l_run = hi == 0 ? 1.0f : 0.0f; }
        f32x16 o[NDVB]; const float zatt = opaque_zero();
#pragma unroll
        for (int d = 0; d < NDVB; ++d)
#pragma unroll
            for (int r = 0; r < 16; ++r) o[d][r] = zatt;
#define ATT_DMA(t, bf) do { const int t_ = (t), bf_ = (bf); const int krow_ = t_ < 4 ? MLAT + b * CTXL + 64 * t_ : b * SEQ + 64 * (lt0 + t_ - 4); \
        _Pragma("unroll") for (int i = 0; i < NKI; ++i) if (wid + 8 * i < KINST) { \
            const unsigned off = (unsigned)(kc[i] + kh[i] * kcol + krow_ * ks[i]); \
            __builtin_amdgcn_global_load_lds((const GAS unsigned*)((const GAS unsigned char*)K + off), (LAS unsigned*)(ldsK + bf_ * KBUF + (wid + 8 * i) * 1024), 16, 0, 0); } \
        _Pragma("unroll") for (int i = 0; i < NVI; ++i) if (wid + 8 * i < VINST) { \
            __builtin_amdgcn_global_load_lds((const GAS unsigned*)((const GAS unsigned char*)(Vt + vrow0 * MTOT + krow_) + (unsigned)vc[i]), (LAS unsigned*)(ldsV + bf_ * VBUF + (wid + 8 * i) * 1024), 16, 0, 0); } } while (0)
#define ATT_WAITBAR(N) asm volatile("s_waitcnt vmcnt(%0) lgkmcnt(0)\n\ts_barrier" :: "n"(N) : "memory")
#define ATT_QK(d0, d1, bf_, t_) do { \
            { f32x16 e0_, e1_;     \
            _Pragma("unroll") for (int r = 0; r < 16; ++r) { d0[r] = 0.f; d1[r] = 0.f; e0_[r] = 0.f; e1_[r] = 0.f; } \
            { const LAS unsigned char* kb0 = ldsK + (bf_) * KBUF + pr * KSTR + hi * 16; const LAS unsigned char* kb1 = kb0 + 32 * KSTR; \
              _Pragma("unroll") for (int dc = 0; dc < NDC; dc += 2) { \
                  const bf16x8 k0 = *(const LAS bf16x8*)(kb0 + dc * 32), k1 = *(const LAS bf16x8*)(kb1 + dc * 32), k2 = *(const LAS bf16x8*)(kb0 + dc * 32 + 32), k3 = *(const LAS bf16x8*)(kb1 + dc * 32 + 32); \
                  d0 = __builtin_amdgcn_mfma_f32_32x32x16_bf16(k0, qf[dc], d0, 0, 0, 0); d1 = __builtin_amdgcn_mfma_f32_32x32x16_bf16(k1, qf[dc], d1, 0, 0, 0); \
                  e0_ = __builtin_amdgcn_mfma_f32_32x32x16_bf16(k2, qf[dc + 1], e0_, 0, 0, 0); e1_ = __builtin_amdgcn_mfma_f32_32x32x16_bf16(k3, qf[dc + 1], e1_, 0, 0, 0); } } \
            _Pragma("unroll") for (int r = 0; r < 16; ++r) { d0[r] += e0_[r]; d1[r] += e1_[r]; } } \
            if (WINDOW && (t_) >= 4) { const int kbase = 64 * (lt0 + (t_) - 4) + 8 * hi - (qblk * 256 + wid * 32 + r32); \
                _Pragma("unroll") for (int r = 0; r < 16; ++r) { const int e0 = kbase + 16 * (r >> 3) + (r & 7), e1 = e0 + 32; \
                    if (e0 > 128 || e0 < -128) d0[r] = -1e30f; if (e1 > 128 || e1 < -128) d1[r] = -1e30f; } } } while (0)
        ATT_DMA(0, 0); ATT_DMA(1, 1);
        ATT_WAITBAR(0);
        int buf = 0, buf1 = 1, buf2 = 2;
        constexpr bool PIPE = false;
        f32x16 s0, s1;
        if (PIPE) ATT_QK(s0, s1, 0, 0);
#pragma unroll 1
        for (int t = 0; t < NT; ++t) {
            if (t + 2 < NT) ATT_DMA(t + 2, buf2);
            f32x16 n0, n1;
            if (PIPE) ATT_QK(n0, n1, buf1, t + 1);
            else ATT_QK(s0, s1, buf, t);
            float mxa = fmaxf(s0[0], s1[0]), mxb = fmaxf(s0[1], s1[1]), mxc = fmaxf(s0[2], s1[2]), mxd = fmaxf(s0[3], s1[3]);
#pragma unroll
            for (int r = 4; r < 16; r += 4) { mxa = fmaxf(mxa, fmaxf(s0[r], s1[r])); mxb = fmaxf(mxb, fmaxf(s0[r + 1], s1[r + 1])); mxc = fmaxf(mxc, fmaxf(s0[r + 2], s1[r + 2])); mxd = fmaxf(mxd, fmaxf(s0[r + 3], s1[r + 3])); }
            float mx = half_max(fmaxf(fmaxf(mxa, mxb), fmaxf(mxc, mxd)));
            if (__builtin_amdgcn_ballot_w64(mx - m_run > 8.0f) != 0ull) {
                const float m_new = fmaxf(m_run, mx), alpha = fast_exp2(m_run - m_new); m_run = m_new; l_run *= alpha;
#pragma unroll
                for (int d = 0; d < NDVB; ++d)
#pragma unroll
                    for (int r = 0; r < 16; ++r) o[d][r] *= alpha;
            }
            float lsa = 0.f, lsb = 0.f, lsc = 0.f, lsd = 0.f;
#pragma unroll
            for (int r = 0; r < 16; r += 2) { s0[r] = fast_exp2(s0[r] - m_run); s1[r] = fast_exp2(s1[r] - m_run); s0[r + 1] = fast_exp2(s0[r + 1] - m_run); s1[r + 1] = fast_exp2(s1[r + 1] - m_run);
                lsa += s0[r]; lsb += s1[r]; lsc += s0[r + 1]; lsd += s1[r + 1]; }
            l_run += (lsa + lsb) + (lsc + lsd);
            bf16x8 pf[4];
            { u32x4 w;
              w.x = pk2(s0[0], s0[1]); w.y = pk2(s0[2], s0[3]); w.z = pk2(s0[4], s0[5]); w.w = pk2(s0[6], s0[7]); pf[0] = __builtin_bit_cast(bf16x8, w);
              w.x = pk2(s0[8], s0[9]); w.y = pk2(s0[10], s0[11]); w.z = pk2(s0[12], s0[13]); w.w = pk2(s0[14], s0[15]); pf[1] = __builtin_bit_cast(bf16x8, w);
              w.x = pk2(s1[0], s1[1]); w.y = pk2(s1[2], s1[3]); w.z = pk2(s1[4], s1[5]); w.w = pk2(s1[6], s1[7]); pf[2] = __builtin_bit_cast(bf16x8, w);
              w.x = pk2(s1[8], s1[9]); w.y = pk2(s1[10], s1[11]); w.z = pk2(s1[12], s1[13]); w.w = pk2(s1[14], s1[15]); pf[3] = __builtin_bit_cast(bf16x8, w); }
            { const LAS unsigned char* vb = ldsV + buf * VBUF + r32 * VSTR + hi * 16;
#pragma unroll
              for (int c = 0; c < 4; ++c)
#pragma unroll
                  for (int d = 0; d < NDVB; ++d) { const bf16x8 vf = *(const LAS bf16x8*)(vb + d * 32 * VSTR + c * 32); o[d] = __builtin_amdgcn_mfma_f32_32x32x16_bf16(vf, pf[c], o[d], 0, 0, 0); } }
            if (PIPE || t + 2 >= NT) ATT_WAITBAR(0); else ATT_WAITBAR(NDMA);
            if (PIPE) { s0 = n0; s1 = n1; }
            buf = buf1; buf1 = buf2; buf2 = buf2 == 2 ? 0 : buf2 + 1;
        }
#undef ATT_QK
#undef ATT_DMA
#undef ATT_WAITBAR
        const float inv = 1.0f / half_sum(l_run);
        gb op = O + (size_t)(qrow0 + wid * 32 + r32) * ldo + head * DV + 8 * hi;
#pragma unroll
        for (int d = 0; d < NDVB; ++d)
#pragma unroll
            for (int p = 0; p < 2; ++p) {
                const unsigned ax = pk2(o[d][8 * p] * inv, o[d][8 * p + 1] * inv), ay = pk2(o[d][8 * p + 2] * inv, o[d][8 * p + 3] * inv);
                const unsigned bx = pk2(o[d][8 * p + 4] * inv, o[d][8 * p + 5] * inv), by = pk2(o[d][8 * p + 6] * inv, o[d][8 * p + 7] * inv);
                const auto r1 = __builtin_amdgcn_permlane32_swap(ax, bx, false, false), r2 = __builtin_amdgcn_permlane32_swap(ay, by, false, false);
                u32x4 w; w.x = r1[0]; w.y = r2[0]; w.z = r1[1]; w.w = r2[1];
                *(GAS u32x4*)(op + 32 * d + 16 * p) = w; }
    }
}

#define XB_TMO      128
#define XB_XCNT(j)  (256  + 64 * (j))
#define XB_XSUB(j)  (1280 + 64 * (j))
#define XB_XGEN(j)  (2304 + 64 * (j))
#define XB_TOP      3328
#define XB_TOPGEN   3392
#define XCD_BAR_WORDS 3456
#define XB_SPIN_CAP (1u << 21)

__device__ __forceinline__ unsigned xb_ld(unsigned* p)              { return __hip_atomic_load(p, __ATOMIC_RELAXED, __HIP_MEMORY_SCOPE_AGENT); }
__device__ __forceinline__ unsigned xb_add(unsigned* p, unsigned v) { return __hip_atomic_fetch_add(p, v, __ATOMIC_RELAXED, __HIP_MEMORY_SCOPE_AGENT); }
__device__ __forceinline__ unsigned xb_xcc_id() { return (unsigned)__builtin_amdgcn_s_getreg((3 << 11) | 20) & 0xFu; }
#define XB_SPIN(cond, bar) do { unsigned _sp = 0; while (cond) { __builtin_amdgcn_s_sleep(1); \
    if ((++_sp & 255u) == 0u) { if (xb_ld(&(bar)[XB_TMO])) break; if (_sp > XB_SPIN_CAP) { atomicAdd(&(bar)[XB_TMO], 1u); break; } } } } while (0)

struct XcdBarrier {
    unsigned* bar; unsigned x;
    volatile LAS unsigned* st;
};

__device__ __forceinline__ XcdBarrier xcd_barrier_post(unsigned* bar, volatile LAS unsigned* st) {
    XcdBarrier b; b.bar = bar; b.x = xb_xcc_id(); b.st = st;
    if (threadIdx.x == 0) (void)xb_add(&bar[XB_XCNT(b.x)], 1u);
    return b;
}
__device__ __forceinline__ void xcd_barrier_complete(unsigned* bar, unsigned x, unsigned& nloc, unsigned& nx) {
    const unsigned G = gridDim.x * gridDim.y * gridDim.z;
    unsigned sum, cnt, mine, sp = 0u;
    for (;;) {
        sum = 0u; cnt = 0u; mine = 0u;
#pragma unroll
        for (unsigned j = 0; j < 16; ++j) { const unsigned c = xb_ld(&bar[XB_XCNT(j)]); sum += c; cnt += (c > 0u) ? 1u : 0u; mine = (j == x) ? c : mine; }
        if (sum == G) break;
        __builtin_amdgcn_s_sleep(1);
        if ((++sp & 255u) == 0u) { if (xb_ld(&bar[XB_TMO])) break; if (sp > XB_SPIN_CAP) { atomicAdd(&bar[XB_TMO], 1u); break; } }
    }
    nloc = mine > 0u ? mine : 1u; nx = cnt > 0u ? cnt : 1u;
}

__device__ __forceinline__ void xcd_barrier(const XcdBarrier& b) {
    asm volatile("s_waitcnt vmcnt(0)" ::: "memory");
    __syncthreads();
    if (threadIdx.x == 0) {
        unsigned* bar = b.bar;
        __builtin_amdgcn_s_waitcnt(0);
        unsigned nloc = b.st[0], nx = b.st[1];
        if (nloc == 0u) { xcd_barrier_complete(bar, b.x, nloc, nx); b.st[0] = nloc; b.st[1] = nx; }
        const unsigned old = xb_add(&bar[XB_XSUB(b.x)], 1u);
        const unsigned gen = old / nloc;
        if (old + 1u == (gen + 1u) * nloc) {
            __builtin_amdgcn_fence(__ATOMIC_RELEASE, "agent");
            asm volatile("s_waitcnt vmcnt(0)" ::: "memory");
            const unsigned og = xb_add(&bar[XB_TOP], 1u);
            const unsigned tg = og / nx;
            if (og + 1u == (tg + 1u) * nx) xb_add(&bar[XB_TOPGEN], 1u);
            else XB_SPIN(xb_ld(&bar[XB_TOPGEN]) == tg, bar);
            __builtin_amdgcn_fence(__ATOMIC_ACQUIRE, "agent");
            xb_add(&bar[XB_XGEN(b.x)], 1u);
            asm volatile("s_waitcnt vmcnt(0)" ::: "memory");
        } else {
            XB_SPIN(xb_ld(&bar[XB_XGEN(b.x)]) == gen, bar);
            __builtin_amdgcn_fence(__ATOMIC_ACQUIRE, "agent");
            asm volatile("s_waitcnt vmcnt(0)" ::: "memory");
        }
    }
    __syncthreads();
}

#define KARG(i) ((gcf)(*(const __attribute__((address_space(4))) unsigned long long*)(kp + 8 * (i))))
#define PHASE_BEGIN int tid_ = threadIdx.x; asm volatile("" : "+v"(tid_)); const int tid = tid_, lane = tid & 63, wid = __builtin_amdgcn_readfirstlane(tid >> 6); const __attribute__((address_space(4))) unsigned char* kp = (const __attribute__((address_space(4))) unsigned char*)__builtin_amdgcn_kernarg_segment_ptr(); asm volatile("" : "+s"(kp)); int G = gridDim.x, bx = __builtin_amdgcn_readfirstlane((int)MISC[5]); asm volatile("" : "+s"(G), "+s"(bx)); const int vcu = __builtin_amdgcn_readfirstlane((int)MISC[4]); Ptrs P; P.bx = bx; P.G = G; P.x = KARG(0); P.c = KARG(1); P.ctx = KARG(2); P.c_ctx = KARG(3); P.w_mod = KARG(4); P.b_mod = KARG(5); P.g_norm = KARG(6); P.w_ffn_in = KARG(7); P.w_ffn_out = KARG(8); P.a_w_in = KARG(9); P.a_g_q = KARG(10); P.a_g_kv = KARG(11); P.a_w_qb = KARG(12); P.a_w_kvb = KARG(13); P.a_w_o = KARG(14); P.b_w_qkv = KARG(15); P.b_lambda = KARG(16); P.b_g_sub = KARG(17); P.b_w_o = KARG(18); P.c_w_qkv = KARG(19); P.c_sink = KARG(20); P.c_w_o = KARG(21); P.g_final = KARG(22); P.out = (gf)KARG(23); P.ws = (GAS unsigned char*)KARG(24);
struct Args { const float* in[23]; float* out; unsigned char* ws; int ph_lo, ph_hi; };

__global__ void __launch_bounds__(512, 2) fwd_kernel(Args args) {
    extern __shared__ __attribute__((aligned(16))) unsigned char lds_raw[];
    LAS unsigned char* lds = (LAS unsigned char*)lds_raw;
    cg::grid_group grid = cg::this_grid();
    volatile LAS unsigned* MISC = (volatile LAS unsigned*)(lds + 143360 + 512);
    if (threadIdx.x < 8) MISC[threadIdx.x] = 0u;
    __syncthreads();
    if (threadIdx.x == 0) {
        const unsigned x = xb_xcc_id(); unsigned* bar0 = (unsigned*)(args.ws + WS_BAR);
        const unsigned rank = xb_add(&bar0[XB_XCNT(x)], 1u);
        const unsigned G0 = gridDim.x, bx0 = blockIdx.x;
        MISC[2] = rank; MISC[3] = x; MISC[4] = (G0 % 8 == 0) ? (bx0 % 8) * (G0 / 8) + bx0 / 8 : bx0; MISC[5] = bx0;
    }
    __syncthreads();

    for (int ph = args.ph_lo; ph < args.ph_hi; ++ph) {
        const unsigned pw = __builtin_amdgcn_readfirstlane(PROG_D.e[ph]);
        const int op = pw & 0xff, l = (pw >> 8) & 0xff, sraw = (pw >> 16) & 0xff, s = sraw & 3, rep = sraw >> 7;
#ifdef ONLY_OP
        if (op != ONLY_OP) continue;
#endif
        const int kind = l % 3;
#ifdef ONLY_KIND
        if (kind != ONLY_KIND) continue;
#endif
#define PHASE_LOCALS gcb Wl = (gcb)(P.ws + WS_W0 + (size_t)(l & 1) * WS_WSZ); gcb HN = (gcb)(P.ws + WS_HN); GAS unsigned char* Sb = P.ws + WS_S; gcf tab = (gcf)(P.ws + WS_TAB); gcf modl = (gcf)(P.ws + WS_MODS) + (size_t)l * 9 * NMODC; gf X = (gf)(P.ws + WS_X); \
        (void)Wl; (void)HN; (void)Sb; (void)tab; (void)modl; (void)X; (void)tid; (void)lane; (void)wid; (void)vcu;
        switch (op) {
        case OP_PRO: { PHASE_BEGIN PHASE_LOCALS prologue(P, lds, tid, wid, lane); } break;
        case OP_NORM: { PHASE_BEGIN PHASE_LOCALS
            norm_phase(P, l, s, wid, lane);
            if (s == 0 && l + 1 < 4) conv_layer(P, l + 1, lds, tid, wid, lane);
        } break;
        case OP_FFN_IN: { PHASE_BEGIN PHASE_LOCALS
            const int M = (l == 3 && s == 1) ? MLAT : MTOT;
            EpiSwiglu E{(gb)(Sb + S_HH)};
            run_gemm(lds, G, bx, HN, Wl + (s ? OFF_WIN1 : OFF_WIN0), M, 2 * DFF, DM, E);
        } break;
        case OP_FFN_OUT: case OP_MIX_OUT: { PHASE_BEGIN PHASE_LOCALS
            const bool ffn = (op == OP_FFN_OUT);
            const int M = (l == 3 && (!ffn || s == 1)) ? MLAT : MTOT;
            EpiResid E{(gcf)X, (gcf)(X + (size_t)MLAT * DM), X, modl + (size_t)(ffn ? (s ? 8 : 2) : 5) * DM, rep ? 0u : (ffn ? 0x3f000000u : 0x3f800000u)};
            gcb A = ffn ? (gcb)(Sb + S_HH) : HN;
            gcb Bt = ffn ? Wl + (s ? OFF_WOUT1 : OFF_WOUT0) : Wl + OFF_MIX + (kind == 0 ? MLA_WO : kind == 1 ? DIF_WO : SWA_WO);
            run_gemm(lds, G, bx, A, Bt, M, DM, ffn ? DFF : DM, E, ffn && (!rep || PROBE_SKIP_EPI));
        } break;
        case OP_MLA_IN: { PHASE_BEGIN PHASE_LOCALS
            EpiF32 E{(gf)(Sb + S_A), 768};
            run_gemm(lds, G, bx, HN, Wl + OFF_MIX + MLA_WA, MTOT, 768, DM, E);
        } break;
        case OP_MLA_ROW: { PHASE_BEGIN PHASE_LOCALS mla_row_phase(P, l, wid, lane); } break;
        case OP_PROJ: { PHASE_BEGIN PHASE_LOCALS
            if (kind == 0) {
                { EpiRope E{(gb)(Sb + S_Q), 1536, 192, 128, 1536, 0.07216878364870322f * LOG2E, tab};
                  run_gemm(lds, G, bx, (gcb)(Sb + S_CQN), Wl + OFF_MIX + MLA_WQB, MTOT, 1536, 384, E); }
                { EpiStoreBf16 E{(gb)(Sb + S_KN), 1024};
                  run_gemm(lds, G, bx, (gcb)(Sb + S_CKVN), Wl + OFF_MIX + MLA_WKN, MTOT, 1024, 256, E); }
                { EpiStoreBf16 E{(gb)(Sb + S_VT_MLA), MTOT};
                  run_gemm(lds, G, bx, Wl + OFF_MIX + MLA_WVT, (gcb)(Sb + S_CKVN), 1024, MTOT, 256, E); }
            } else {
                const int nqk = kind == 1 ? 2048 : 1280, nv = kind == 1 ? 1024 : 256;
                { EpiRope E{(gb)(Sb + S_QK), nqk, 64, 0, 1024, 0.125f * LOG2E, tab};
                  run_gemm(lds, G, bx, HN, Wl + OFF_MIX + (kind == 1 ? DIF_WQK : SWA_WQK), MTOT, nqk, DM, E); }
                { EpiStoreBf16 E{(gb)(Sb + (kind == 1 ? S_VT_DIFF : S_VT_SWA)), MTOT};
                  run_gemm(lds, G, bx, Wl + OFF_MIX + (kind == 1 ? DIF_WV : SWA_WV), HN, nv, MTOT, DM, E); }
            }
        } break;
        case OP_ATT: { PHASE_BEGIN PHASE_LOCALS
            if (kind == 0)
                attn_phase<192, 128, true, false, false>(lds, (gcb)(Sb + S_Q), 1536, (gcb)(Sb + S_KN), 1024, (gcb)(Sb + S_KR), (gcb)(Sb + S_VT_MLA), (gb)(P.ws + WS_HN), 1024, 8, 1, 1, P.c_sink, l < 3, vcu, G);
            else if (kind == 1)
                attn_phase<64, 128, false, false, false>(lds, (gcb)(Sb + S_QK), 2048, (gcb)(Sb + S_QK) + 1024, 2048, (gcb)(Sb + S_QK), (gcb)(Sb + S_VT_DIFF), (gb)(Sb + S_O2), 2048, 16, 1, 2, P.c_sink, true, vcu, G);
            else
                attn_phase<64, 64, false, true, true>(lds, (gcb)(Sb + S_QK), 1280, (gcb)(Sb + S_QK) + 1024, 1280, (gcb)(Sb + S_QK), (gcb)(Sb + S_VT_SWA), (gb)(P.ws + WS_HN), 1024, 16, 4, 4, P.c_sink, true, vcu, G);
        } break;
        case OP_DIFF_ROW: { PHASE_BEGIN PHASE_LOCALS diff_row_phase(P, wid, lane); } break;
        case OP_FINAL: { PHASE_BEGIN PHASE_LOCALS final_phase(P, wid, lane); } break;
        default: break;
        }
        __syncthreads();
        if (ph + 1 < args.ph_hi) {
            if (ph == 0) { grid.sync();
                if (threadIdx.x == 0) {
                    unsigned* bar0 = (unsigned*)(args.ws + WS_BAR); const unsigned x = MISC[3], rank = MISC[2], G0 = gridDim.x;
                    unsigned pre = 0u, idx = 0u, nx = 0u; bool uni = true;
                    for (unsigned j = 0; j < 16; ++j) { const unsigned cj = xb_ld(&bar0[XB_XCNT(j)]); if (j < x) { pre += cj; idx += cj ? 1u : 0u; } if (cj) { ++nx; if (cj * 8u != G0) uni = false; } }
                    if (nx == 8u && uni) { MISC[4] = pre + rank; MISC[5] = rank * 8u + idx; }
                }
                __syncthreads(); }
            else { XcdBarrier b; b.bar = (unsigned*)(args.ws + WS_BAR); b.x = xb_xcc_id(); b.st = MISC; xcd_barrier(b); if (DUP_SYNC) xcd_barrier(b); }
        }
    }
}

#ifndef N_LAUNCH_MODE
#define N_LAUNCH_MODE 1
#endif
extern "C" void kernel_launch(void* const* d_in, const int* in_sizes, int n_in, void* d_out, int out_size, void* d_ws, size_t ws_size, hipStream_t stream) {
    static int grid = 0;
    if (grid == 0) {
        if (n_in != 23 || out_size != MLAT * DM || ws_size < WS_END) { fprintf(stderr, "kernel_launch: unexpected problem (n_in %d out %d ws %zu need %zu)\n", n_in, out_size, ws_size, (size_t)WS_END); grid = -1; return; }
        int dev = 0, cus = 0, per_cu = 0;
        hipGetDevice(&dev); hipDeviceGetAttribute(&cus, hipDeviceAttributeMultiprocessorCount, dev);
        if (hipFuncSetAttribute((const void*)fwd_kernel, hipFuncAttributeMaxDynamicSharedMemorySize, LDS_BYTES) != hipSuccess) { fprintf(stderr, "kernel_launch: hipFuncSetAttribute failed\n"); grid = -1; return; }
        if (hipOccupancyMaxActiveBlocksPerMultiprocessor(&per_cu, (const void*)fwd_kernel, 512, LDS_BYTES) != hipSuccess || per_cu < 1) { fprintf(stderr, "kernel_launch: occupancy query gave %d\n", per_cu); per_cu = 1; }
        (void)hipGetLastError();
        grid = cus * 1;
    }
    if (grid < 0) return;
    if (hipMemsetAsync((char*)d_ws + WS_BAR, 0, BAR_ZERO_BYTES, stream) != hipSuccess) { fprintf(stderr, "kernel_launch: memset of barrier words failed\n"); return; }
    Args a{};
    for (int i = 0; i < 23; ++i) a.in[i] = (const float*)d_in[i];
    a.out = (float*)d_out; a.ws = (unsigned char*)d_ws;
#if N_LAUNCH_MODE == 1
    a.ph_lo = 0; a.ph_hi = NPHASE;
    { void* kargs[] = {&a}; hipError_t e = hipLaunchCooperativeKernel((const void*)fwd_kernel, dim3(grid), dim3(512), kargs, LDS_BYTES, stream);
      if (e != hipSuccess) fprintf(stderr, "cooperative launch failed: %s (grid %d)\n", hipGetErrorString(e), grid); }
#else
    for (int ph = 0; ph < NPHASE; ++ph) { a.ph_lo = ph; a.ph_hi = ph + 1; void* kargs[] = {&a};
        hipError_t e = hipLaunchCooperativeKernel((const void*)fwd_kernel, dim3(grid), dim3(512), kargs, LDS_BYTES, stream);
        if (e != hipSuccess) { fprintf(stderr, "launch %d failed: %s\n", ph, hipGetErrorString(e)); break; } }
#endif
}
```
